# Optimizing an MI355X kernel written in HIP

```python
import jax, jax.numpy as jnp
from jax import lax
import numpy as np

D_MODEL = 2048
BATCH = 32
SEQ = 256
DEPTH = 4
DEC_BATCH = 8
DEC_SEQ = 1024
PAST_LEN = 256

GRID_W = 64
HD = 128
MIX_WIDTH = 1024
N_BRANCH = 4
POOL_GROUPS = 4
POOL_GROUP_DIM = MIX_WIDTH // POOL_GROUPS
POOL_WINDOWS = (2, 4, 8, 16)
B_HEADS = 8
B_KV_HEADS = 2
GQA_GROUP = B_HEADS // B_KV_HEADS
B_WINDOW = 128
B_BLOCK = 128
C_HEADS = 8
NA_KH = 8
NA_KW = 16
SSM_HEADS = 16
SSM_HEADDIM = 64
SSM_INNER = SSM_HEADS * SSM_HEADDIM
SSM_GROUPS = 2
SSM_STATE = 64
SSM_CONV = 5
SSM_CHUNK = 128
SSM_XBC = SSM_INNER + 2 * SSM_GROUPS * SSM_STATE
D_FF = 4 * D_MODEL
Q_BLOCK = 128
ROPE_BASE = 10000.0
LN_EPS = 1e-5
RMS_EPS = 1e-6
NEG_INF = -1e30
ALPHA = (2 * DEPTH) ** 0.25
BETA = (8 * DEPTH) ** -0.25
IN_SIZES = (MIX_WIDTH, B_HEADS * HD, B_KV_HEADS * HD, B_KV_HEADS * HD, C_HEADS * HD, C_HEADS * HD, C_HEADS * HD, SSM_INNER, SSM_XBC, 2 * SSM_HEADS, N_BRANCH * D_MODEL)
D_IN = sum(IN_SIZES)

kernel_name = 'hybrid_pool_swa_natten_ssd_diffusion_step'


def layer_norm(x, g, b):
    xf = x.astype(jnp.float32)
    mu = jnp.mean(xf, axis=-1, keepdims=True)
    var = jnp.mean(jnp.square(xf - mu), axis=-1, keepdims=True)
    return ((xf - mu) * lax.rsqrt(var + LN_EPS)).astype(x.dtype) * g + b


def rms_norm(x, g):
    xf = x.astype(jnp.float32)
    return (xf * lax.rsqrt(jnp.mean(jnp.square(xf), axis=-1, keepdims=True) + RMS_EPS)).astype(x.dtype) * g


def modulation(cvec, w_ada, b_ada):
    return jnp.split(jax.nn.silu(cvec) @ w_ada + b_ada, 6, axis=-1)


def rope_2d(x):
    L = x.shape[1]
    t = jnp.arange(L)
    half = HD // 2
    quarter = half // 2
    freqs = ROPE_BASE ** (-jnp.arange(quarter, dtype=jnp.float32) / quarter)

    def rotate(xa, pos):
        ang = pos.astype(jnp.float32)[:, None] * freqs[None, :]
        cos = jnp.cos(ang)[None, :, None, :].astype(xa.dtype)
        sin = jnp.sin(ang)[None, :, None, :].astype(xa.dtype)
        x1, x2 = xa[..., :quarter], xa[..., quarter:]
        return jnp.concatenate([x1 * cos - x2 * sin, x1 * sin + x2 * cos], axis=-1)

    return jnp.concatenate([rotate(x[..., :half], t // GRID_W), rotate(x[..., half:], t % GRID_W)], axis=-1)


def pool_mix(a, w_pool, pool_scale):
    bsz, L, _ = a.shape
    ag = a.reshape(bsz, L, POOL_GROUPS, POOL_GROUP_DIM)
    cs = jnp.pad(jnp.cumsum(ag.astype(jnp.float32), axis=1), ((0, 0), (1, 0), (0, 0), (0, 0)))
    pos = jnp.arange(L)
    pooled = []
    for g, w in enumerate(POOL_WINDOWS):
        lo = jnp.clip(pos - w // 2, 0, L)
        hi = jnp.clip(pos + w - w // 2, 0, L)
        csg = cs[:, :, g]
        cnt = (hi - lo).astype(jnp.float32)[None, :, None]
        pooled.append((csg[:, hi] - csg[:, lo]) / cnt)
    pooled = jnp.stack(pooled, axis=2).astype(a.dtype) - ag
    y = jnp.einsum('blgc,gcd->blgd', pooled, w_pool)
    return y.reshape(bsz, L, MIX_WIDTH) * pool_scale


def dense_ctx_attention(q, k, v, sink):
    bsz, s_len, kvh, grp, _ = q.shape
    nb = s_len // Q_BLOCK
    qb = jnp.moveaxis(q.reshape(bsz, nb, Q_BLOCK, kvh, grp, HD), 1, 0)
    scale = HD ** -0.5

    def block(q_blk):
        s = jnp.einsum('bqhgd,bkhd->bhgqk', q_blk, k).astype(jnp.float32) * scale
        if sink is not None:
            s_sink = jnp.broadcast_to(sink.astype(jnp.float32)[None, :, :, None, None], s.shape[:-1] + (1,))
            s = jnp.concatenate([s, s_sink], axis=-1)
        p = jax.nn.softmax(s, axis=-1)[..., :s_len].astype(v.dtype)
        return jnp.einsum('bhgqk,bkhd->bqhgd', p, v)

    o = lax.map(block, qb)
    return jnp.moveaxis(o, 0, 1).reshape(bsz, s_len, kvh * grp * HD)


def band_gqa_latent(q, k, v, ck, cv, sink):
    bsz, L = q.shape[:2]
    nb = L // B_BLOCK
    span = B_BLOCK + 2 * B_WINDOW
    kp = jnp.pad(k, ((0, 0), (B_WINDOW, B_WINDOW), (0, 0), (0, 0)))
    vp = jnp.pad(v, ((0, 0), (B_WINDOW, B_WINDOW), (0, 0), (0, 0)))
    idx = jnp.arange(nb)[:, None] * B_BLOCK + jnp.arange(span)[None, :]
    kb, vb = kp[:, idx], vp[:, idx]
    qb = q.reshape(bsz, nb, B_BLOCK, B_KV_HEADS, GQA_GROUP, HD)
    scale = HD ** -0.5
    s_loc = jnp.einsum('bnqhgd,bnkhd->bnhgqk', qb, kb).astype(jnp.float32) * scale
    kpos = idx - B_WINDOW
    qpos = jnp.arange(L).reshape(nb, B_BLOCK)
    valid = (kpos[:, None, :] >= 0) & (kpos[:, None, :] < L) & (jnp.abs(qpos[:, :, None] - kpos[:, None, :]) <= B_WINDOW)
    s_loc = jnp.where(valid[None, :, None, None, :, :], s_loc, NEG_INF)
    s_ctx = jnp.einsum('bnqhgd,bphd->bnhgqp', qb, ck).astype(jnp.float32) * scale
    s_sink = jnp.broadcast_to(sink.astype(jnp.float32).reshape(1, 1, B_KV_HEADS, GQA_GROUP, 1, 1), s_loc.shape[:-1] + (1,))
    p = jax.nn.softmax(jnp.concatenate([s_loc, s_ctx, s_sink], axis=-1), axis=-1).astype(v.dtype)
    n_ctx = ck.shape[1]
    o = jnp.einsum('bnhgqk,bnkhd->bnqhgd', p[..., :span], vb) + jnp.einsum('bnhgqp,bphd->bnqhgd', p[..., span:span + n_ctx], cv)
    return o.reshape(bsz, L, B_HEADS * HD)


def neighbourhood_attn_latent(q, k, v, ck, cv, rpb):
    bsz, L = q.shape[:2]
    rows = L // GRID_W
    kh = min(NA_KH, rows)
    r = jnp.arange(rows)
    r0 = jnp.clip(r - kh // 2, 0, rows - kh)
    key_rows = r0[:, None] + jnp.arange(kh)[None, :]
    col = jnp.arange(GRID_W)
    c0 = jnp.clip(col - NA_KW // 2, 0, GRID_W - NA_KW)
    qg = q.reshape(bsz, rows, GRID_W, C_HEADS, HD)
    kg = k.reshape(bsz, rows, GRID_W, C_HEADS, HD)[:, key_rows]
    vg = v.reshape(bsz, rows, GRID_W, C_HEADS, HD)[:, key_rows]
    scale = HD ** -0.5
    s_loc = jnp.einsum('brqhd,brjkhd->brhqjk', qg, kg).astype(jnp.float32) * scale
    dr_i = key_rows - r[:, None] + (NA_KH - 1)
    dc_i = jnp.clip(col[None, :] - col[:, None], -(NA_KW - 1), NA_KW - 1) + (NA_KW - 1)
    bias = rpb[:, dr_i[:, None, :, None], dc_i[None, :, None, :]]
    s_loc = s_loc + jnp.moveaxis(bias, 0, 1).astype(jnp.float32)[None]
    col_ok = (col[None, :] >= c0[:, None]) & (col[None, :] < c0[:, None] + NA_KW)
    s_loc = jnp.where(col_ok[None, None, None, :, None, :], s_loc, NEG_INF).reshape(bsz, rows, C_HEADS, GRID_W, kh * GRID_W)
    s_ctx = jnp.einsum('brqhd,bphd->brhqp', qg, ck).astype(jnp.float32) * scale
    p = jax.nn.softmax(jnp.concatenate([s_loc, s_ctx], axis=-1), axis=-1).astype(v.dtype)
    p_loc = p[..., :kh * GRID_W].reshape(bsz, rows, C_HEADS, GRID_W, kh, GRID_W)
    o = jnp.einsum('brhqjk,brjkhd->brqhd', p_loc, vg) + jnp.einsum('brhqp,bphd->brqhd', p[..., kh * GRID_W:], cv)
    return o.reshape(bsz, L, C_HEADS * HD)


def dw_conv_centred(x, w, b):
    pad = SSM_CONV // 2
    y = lax.conv_general_dilated(x, w[:, None, :], window_strides=(1,), padding=[(pad, pad)],
                                 dimension_numbers=('NWC', 'WIO', 'NWC'), feature_group_count=x.shape[-1])
    return y + b


def ssd_scan(x, dt, a, bm, cm, h0):
    f32 = jnp.float32
    bsz, L, H, P = x.shape
    nc, Q = L // SSM_CHUNK, SSM_CHUNK
    rep = SSM_HEADS // SSM_GROUPS
    xc = x.astype(f32).reshape(bsz, nc, Q, H, P)
    bc = jnp.repeat(bm.astype(f32), rep, axis=2).reshape(bsz, nc, Q, H, SSM_STATE)
    cc = jnp.repeat(cm.astype(f32), rep, axis=2).reshape(bsz, nc, Q, H, SSM_STATE)
    dtc = dt.astype(f32).reshape(bsz, nc, Q, H)
    cum = jnp.cumsum(dtc * a, axis=2)
    lower = jnp.tril(jnp.ones((Q, Q), dtype=bool))[None, None, :, :, None]
    seg = jnp.exp(jnp.where(lower, cum[:, :, :, None, :] - cum[:, :, None, :, :], NEG_INF))
    w_intra = jnp.einsum('bcihn,bcjhn->bcijh', cc, bc) * seg * dtc[:, :, None, :, :]
    y_intra = jnp.einsum('bcijh,bcjhp->bcihp', w_intra, xc)
    w_state = jnp.exp(cum[:, :, -1:, :] - cum) * dtc
    states = jnp.einsum('bcjh,bcjhn,bcjhp->bchpn', w_state, bc, xc)
    chunk_decay = jnp.exp(cum[:, :, -1, :])

    def step(h, inp):
        st, dec = inp
        return h * dec[:, :, None, None] + st, h

    h_fin, h_prev = lax.scan(step, h0.astype(f32), (jnp.moveaxis(states, 1, 0), jnp.moveaxis(chunk_decay, 1, 0)))
    h_prev = jnp.moveaxis(h_prev, 0, 1)
    y_inter = jnp.einsum('bcihn,bchpn->bcihp', cc, h_prev) * jnp.exp(cum)[..., None]
    y = (y_intra + y_inter).reshape(bsz, L, H, P)
    return y.astype(x.dtype), h_fin.astype(h0.dtype)


def ssd_mixer(z, xbc, dtr, conv_w, conv_b, a_log, dt_bias, d_skip, norm_g, h0_pair):
    bsz, L, _ = z.shape
    xbc = jax.nn.silu(dw_conv_centred(xbc, conv_w, conv_b))
    xs, bm, cm = jnp.split(xbc, [SSM_INNER, SSM_INNER + SSM_GROUPS * SSM_STATE], axis=-1)
    xs = xs.reshape(bsz, L, SSM_HEADS, SSM_HEADDIM)
    bm = bm.reshape(bsz, L, SSM_GROUPS, SSM_STATE)
    cm = cm.reshape(bsz, L, SSM_GROUPS, SSM_STATE)
    dt = jax.nn.softplus(dtr.reshape(bsz, L, 2, SSM_HEADS) + dt_bias)
    a = -jnp.exp(a_log.astype(jnp.float32))
    y_f, h_f = ssd_scan(xs, dt[:, :, 0], a[0], bm, cm, h0_pair[0])
    y_b, h_b = ssd_scan(xs[:, ::-1], dt[:, ::-1, 1], a[1], bm[:, ::-1], cm[:, ::-1], h0_pair[1])
    y = y_f + y_b[:, ::-1] + xs * d_skip[:, None]
    y = y.reshape(bsz, L, SSM_INNER) * jax.nn.silu(z)
    return rms_norm(y, norm_g), jnp.stack([h_f, h_b], axis=1)


def trunk_layer(x, mod, ctx_kv, h0_pair, latent, w_in, w_pool, pool_scale, sink, rpb, conv_w, conv_b,
                a_log, dt_bias, d_skip, ssm_norm, w_branch, w_o, ln1_g, ln1_b, w_mlp1, w_mlp2, ln2_g, ln2_b):
    shift1, scale1, gate1, shift2, scale2, gate2 = mod
    bsz, L, _ = x.shape
    h = x * (1 + scale1) + shift1
    splits = np.cumsum(IN_SIZES)[:-1].tolist()
    a, qb, kb, vb, qc, kc, vc, z, xbc, dtr, gates = jnp.split(h @ w_in, splits, axis=-1)
    y_a = pool_mix(a, w_pool, pool_scale)
    qb = qb.reshape(bsz, L, B_HEADS, HD)
    kb = kb.reshape(bsz, L, B_KV_HEADS, HD)
    vb = vb.reshape(bsz, L, B_KV_HEADS, HD)
    qc = qc.reshape(bsz, L, C_HEADS, HD)
    kc = kc.reshape(bsz, L, C_HEADS, HD)
    vc = vc.reshape(bsz, L, C_HEADS, HD)
    if latent:
        ck_b, cv_b, ck_c, cv_c = ctx_kv
        kb = rope_2d(kb)
        y_b = band_gqa_latent(rope_2d(qb).reshape(bsz, L, B_KV_HEADS, GQA_GROUP, HD), kb, vb, ck_b, cv_b, sink)
        y_c = neighbourhood_attn_latent(qc, kc, vc, ck_c, cv_c, rpb)
    else:
        y_b = dense_ctx_attention(qb.reshape(bsz, L, B_KV_HEADS, GQA_GROUP, HD), kb, vb, sink.reshape(B_KV_HEADS, GQA_GROUP))
        y_c = dense_ctx_attention(qc[:, :, :, None, :], kc, vc, None)
    y_d, h_fin = ssd_mixer(z, xbc, dtr, conv_w, conv_b, a_log, dt_bias, d_skip, ssm_norm, h0_pair)
    branches = jnp.stack([y_a, y_b, y_c, y_d], axis=2)
    proj = jnp.einsum('blnm,nmd->blnd', branches, w_branch)
    g = jax.nn.sigmoid(gates.reshape(bsz, L, N_BRANCH, D_MODEL))
    merged = jnp.sum(g * proj, axis=2) @ w_o
    x = layer_norm(ALPHA * x + gate1 * merged, ln1_g, ln1_b)
    h2 = x * (1 + scale2) + shift2
    ff = jnp.square(jax.nn.relu(h2 @ w_mlp1)) @ w_mlp2
    x = layer_norm(ALPHA * x + gate2 * ff, ln2_g, ln2_b)
    return x, (kb, vb, kc, vc, h_fin)


def setup_inputs(seed: int = 0) -> dict:
    key = jax.random.key(seed)
    ks = jax.random.split(key, 32)
    f32 = jnp.float32

    def nrm(k, shape, s):
        return jax.random.normal(k, shape, f32) * s

    return {
        'x_prompt': nrm(ks[0], (BATCH, SEQ, D_MODEL), 1.0),
        'x_sample': nrm(ks[1], (DEC_BATCH, DEC_SEQ, D_MODEL), 1.0),
        'cache_b_k': nrm(ks[2], (DEC_BATCH, DEPTH, PAST_LEN, B_KV_HEADS, HD), 1.0),
        'cache_b_v': nrm(ks[3], (DEC_BATCH, DEPTH, PAST_LEN, B_KV_HEADS, HD), 1.0),
        'cache_c_k': nrm(ks[4], (DEC_BATCH, DEPTH, PAST_LEN, C_HEADS, HD), 1.0),
        'cache_c_v': nrm(ks[5], (DEC_BATCH, DEPTH, PAST_LEN, C_HEADS, HD), 1.0),
        'state_ssm': nrm(ks[6], (DEC_BATCH, DEPTH, 2, SSM_HEADS, SSM_HEADDIM, SSM_STATE), 0.1),
        'c': nrm(ks[7], (DEC_BATCH, D_MODEL), 1.0),
        'c_ctx': nrm(ks[8], (D_MODEL,), 1.0),
        'w_ada': nrm(ks[9], (DEPTH, D_MODEL, 6 * D_MODEL), 0.5 * D_MODEL ** -0.5),
        'b_ada': nrm(ks[10], (DEPTH, 6 * D_MODEL), 0.02),
        'w_in': nrm(ks[11], (DEPTH, D_MODEL, D_IN), D_MODEL ** -0.5),
        'w_pool': nrm(ks[12], (DEPTH, POOL_GROUPS, POOL_GROUP_DIM, POOL_GROUP_DIM), POOL_GROUP_DIM ** -0.5),
        'pool_scale': 1.0 + nrm(ks[13], (DEPTH, MIX_WIDTH), 0.02),
        'attn_sink': nrm(ks[14], (DEPTH, B_HEADS), 0.5),
        'na_rpb': nrm(ks[15], (DEPTH, C_HEADS, 2 * NA_KH - 1, 2 * NA_KW - 1), 0.1),
        'conv_w': nrm(ks[16], (DEPTH, SSM_CONV, SSM_XBC), SSM_CONV ** -0.5),
        'conv_b': nrm(ks[17], (DEPTH, SSM_XBC), 0.02),
        'a_log': jnp.log(jax.random.uniform(ks[18], (DEPTH, 2, SSM_HEADS), f32, 1.0, 16.0)),
        'dt_bias': jax.random.uniform(ks[19], (DEPTH, 2, SSM_HEADS), f32, -6.0, -2.0),
        'd_skip': 1.0 + nrm(ks[20], (DEPTH, SSM_HEADS), 0.1),
        'ssm_norm': 1.0 + nrm(ks[21], (DEPTH, SSM_INNER), 0.02),
        'w_branch': nrm(ks[22], (DEPTH, N_BRANCH, MIX_WIDTH, D_MODEL), BETA * MIX_WIDTH ** -0.5),
        'w_o': nrm(ks[23], (DEPTH, D_MODEL, D_MODEL), BETA * D_MODEL ** -0.5),
        'ln1_g': 1.0 + nrm(ks[24], (DEPTH, D_MODEL), 0.02),
        'ln1_b': nrm(ks[25], (DEPTH, D_MODEL), 0.02),
        'w_mlp1': nrm(ks[26], (DEPTH, D_MODEL, D_FF), D_MODEL ** -0.5),
        'w_mlp2': nrm(ks[27], (DEPTH, D_FF, D_MODEL), BETA * D_FF ** -0.5),
        'ln2_g': 1.0 + nrm(ks[28], (DEPTH, D_MODEL), 0.02),
        'ln2_b': nrm(ks[29], (DEPTH, D_MODEL), 0.02),
    }


def reference(x_prompt, x_sample, cache_b_k, cache_b_v, cache_c_k, cache_c_v, state_ssm, c, c_ctx,
              w_ada, b_ada, w_in, w_pool, pool_scale, attn_sink, na_rpb, conv_w, conv_b, a_log, dt_bias,
              d_skip, ssm_norm, w_branch, w_o, ln1_g, ln1_b, w_mlp1, w_mlp2, ln2_g, ln2_b):
    y_prompt = x_prompt
    y_sample = x_sample
    h0 = jnp.zeros((x_prompt.shape[0], SSM_HEADS, SSM_HEADDIM, SSM_STATE), x_prompt.dtype)
    bk, bv, ckk, cvv, hs = [], [], [], [], []
    for l in range(DEPTH):
        lw = (w_in[l], w_pool[l], pool_scale[l], attn_sink[l], na_rpb[l], conv_w[l], conv_b[l], a_log[l],
              dt_bias[l], d_skip[l], ssm_norm[l], w_branch[l], w_o[l], ln1_g[l], ln1_b[l], w_mlp1[l],
              w_mlp2[l], ln2_g[l], ln2_b[l])
        mod_ctx = modulation(c_ctx, w_ada[l], b_ada[l])
        y_prompt, (kb, vb, kc, vc, h_ctx) = trunk_layer(y_prompt, mod_ctx, None, (h0, h0), False, *lw)
        bk.append(kb)
        bv.append(vb)
        ckk.append(kc)
        cvv.append(vc)
        hs.append(h_ctx)
        mod_lat = modulation(c[:, None, :], w_ada[l], b_ada[l])
        ctx_kv = (cache_b_k[:, l], cache_b_v[:, l], cache_c_k[:, l], cache_c_v[:, l])
        y_sample, _ = trunk_layer(y_sample, mod_lat, ctx_kv, (state_ssm[:, l, 0], state_ssm[:, l, 1]), True, *lw)
    new_cache_b_k = jnp.stack(bk, axis=1)
    new_cache_b_v = jnp.stack(bv, axis=1)
    new_cache_c_k = jnp.stack(ckk, axis=1)
    new_cache_c_v = jnp.stack(cvv, axis=1)
    new_state_ssm = jnp.stack(hs, axis=1)
    return (y_prompt, y_sample, new_cache_b_k, new_cache_b_v, new_cache_c_k, new_cache_c_v, new_state_ssm)
```

```cpp
#include <hip/hip_runtime.h>
#include <stdint.h>

#define LAS __attribute__((address_space(3)))
typedef unsigned short bf16_t;
typedef short bf16x8 __attribute__((ext_vector_type(8)));
typedef short s16x4 __attribute__((ext_vector_type(4)));
typedef float f32x2 __attribute__((ext_vector_type(2)));
typedef float f32x4 __attribute__((ext_vector_type(4)));
typedef float f32x16 __attribute__((ext_vector_type(16)));
typedef unsigned u32x2 __attribute__((ext_vector_type(2)));
typedef unsigned u32x4 __attribute__((ext_vector_type(4)));

constexpr int D = 2048, NTOK = 16384, NCTX = 8192, DEPTH = 4, DFF = 8192;
constexpr int ULD = 16384;
constexpr int C_POOL = 0, C_QB = 1024, C_KB = 2048, C_VB = 2304, C_QC = 2560, C_KC = 3584, C_VC = 4608, C_Z = 5632, C_XBC = 6656, C_DT = 7936, C_GATE = 8192;
constexpr int DIN = 16160;
constexpr float ALPHA = 1.6817928305074290f;
constexpr float LN_EPS = 1e-5f, RMS_EPS = 1e-6f, NEG = -1e30f;
constexpr float QSCALE = 0.08838834764831845f;

constexpr size_t O_Y = 0, O_CBK = 33554432, O_CBV = 41943040, O_CCK = 50331648, O_CCV = 83886080, O_ST = 117440512, O_END = 134217728;

constexpr size_t WS_CTL = 0;
constexpr size_t WS_MOD = 65536;
constexpr size_t WS_WIN = WS_MOD + 4ull * 9 * 12288 * 4;
constexpr size_t WS_WPOOL = WS_WIN + 4ull * 16384 * 2048 * 2;
constexpr size_t WS_WB = WS_WPOOL + 4ull * 4 * 256 * 256 * 2;
constexpr size_t WS_WO = WS_WB + 4ull * 4 * 2048 * 1024 * 2;
constexpr size_t WS_W1 = WS_WO + 4ull * 2048 * 2048 * 2;
constexpr size_t WS_W2 = WS_W1 + 4ull * 8192 * 2048 * 2;
constexpr size_t WS_CKB = WS_W2 + 4ull * 8192 * 2048 * 2;
constexpr size_t WS_CVTB = WS_CKB + 8ull * 4 * 256 * 256 * 2;
constexpr size_t WS_CKC = WS_CVTB + 8ull * 4 * 256 * 256 * 2;
constexpr size_t WS_CVTC = WS_CKC + 8ull * 4 * 256 * 1024 * 2;
constexpr size_t WS_H = WS_CVTC + 8ull * 4 * 256 * 1024 * 2;
constexpr size_t WS_U = WS_H + 16384ull * 2048 * 2;
constexpr size_t WS_DTRAW = WS_U + 16384ull * 16384 * 2;
constexpr size_t WS_DT = WS_DTRAW + 16384ull * 32 * 4;
constexpr size_t WS_DEC = WS_DT + 16384ull * 32 * 4;
constexpr size_t WS_POOLED = WS_DEC + 16384ull * 32 * 4;
constexpr size_t WS_XACT = WS_POOLED + 16384ull * 1024 * 2;
constexpr size_t WS_VTB = WS_XACT + 16384ull * 1280 * 4;
constexpr size_t WS_VTC = WS_VTB + 256ull * 16384 * 2;
constexpr size_t WS_Y = WS_VTC + 1024ull * 16384 * 2;
constexpr size_t WS_SSQ = WS_Y + 4ull * 16384 * 1024 * 2;
constexpr size_t WS_MERGED = WS_SSQ + 16384ull * 16 * 4;
constexpr size_t WS_PRE = WS_MERGED + 16384ull * 2048 * 2;
constexpr size_t WS_END = WS_PRE + 16384ull * 2048 * 4;

constexpr int LDS_BYTES = 147456;
constexpr int LDS_MISC = 131072 + 12288;

struct Params {
    const float *x_prompt, *x_sample, *cache_b_k, *cache_b_v, *cache_c_k, *cache_c_v, *state_ssm, *c, *c_ctx;
    const float *w_ada, *b_ada, *w_in, *w_pool, *pool_scale, *attn_sink, *na_rpb, *conv_w, *conv_b, *a_log, *dt_bias, *d_skip, *ssm_norm,
        *w_branch, *w_o, *ln1_g, *ln1_b, *w_mlp1, *w_mlp2, *ln2_g, *ln2_b;
    float* out;
    unsigned char* ws;
};

__device__ __forceinline__ int otid() { int t = threadIdx.x; asm volatile("" : "+v"(t)); return t; }
__device__ __forceinline__ int obid() { int b = blockIdx.x; asm volatile("" : "+s"(b)); return b; }
__device__ __forceinline__ unsigned pk2(float lo, float hi) {
    typedef __bf16 bf2 __attribute__((ext_vector_type(2)));
    f32x2 v = {lo, hi};
    return __builtin_bit_cast(unsigned, __builtin_convertvector(v, bf2));
}
__device__ __forceinline__ float bf2f(unsigned short b) { return __uint_as_float(((unsigned)b) << 16); }
__device__ __forceinline__ float bflo(unsigned w) { return __uint_as_float(w << 16); }
__device__ __forceinline__ float bfhi(unsigned w) { return __uint_as_float(w & 0xffff0000u); }
__device__ __forceinline__ float silu_f(float x) { return x / (1.0f + __expf(-x)); }
__device__ __forceinline__ float sigmoid_f(float x) { return 1.0f / (1.0f + __expf(-x)); }
__device__ __forceinline__ int mod_index(int row) { return row < NCTX ? 0 : 1 + ((row - NCTX) >> 10); }

#define XB_TMO      128
#define XB_XCNT(j)  (256  + 64 * (j))
#define XB_XSUB(j)  (1280 + 64 * (j))
#define XB_XGEN(j)  (2304 + 64 * (j))
#define XB_TOP      3328
#define XB_TOPGEN   3392
#define XCD_BAR_WORDS 3456
#define XB_SPIN_CAP (1u << 20)

__device__ __forceinline__ unsigned xb_ld(unsigned* p)              { return __hip_atomic_load(p, __ATOMIC_RELAXED, __HIP_MEMORY_SCOPE_AGENT); }
__device__ __forceinline__ unsigned xb_add(unsigned* p, unsigned v) { return __hip_atomic_fetch_add(p, v, __ATOMIC_RELAXED, __HIP_MEMORY_SCOPE_AGENT); }
__device__ __forceinline__ unsigned xb_xcc_id() { return (unsigned)__builtin_amdgcn_s_getreg((3 << 11) | 20) & 0xFu; }
#define XB_SPIN(cond, bar) do { unsigned _sp = 0; while (cond) { __builtin_amdgcn_s_sleep(1); \
    if ((++_sp & 255u) == 0u) { if (xb_ld(&(bar)[XB_TMO])) break; if (_sp > XB_SPIN_CAP) { atomicAdd(&(bar)[XB_TMO], 1u); break; } } } } while (0)

struct XcdBarrier { unsigned* bar; unsigned x; volatile LAS unsigned* st; };

__device__ __forceinline__ XcdBarrier xcd_barrier_post(unsigned* bar, volatile LAS unsigned* st) {
    XcdBarrier b; b.bar = bar; b.x = xb_xcc_id(); b.st = st;
    if (threadIdx.x == 0) (void)xb_add(&bar[XB_XCNT(b.x)], 1u);
    return b;
}
__device__ __forceinline__ void xcd_barrier_complete(unsigned* bar, unsigned x, unsigned& nloc, unsigned& nx) {
    const unsigned G = gridDim.x * gridDim.y * gridDim.z;
    unsigned sum, cnt, mine, sp = 0u;
    for (;;) {
        sum = 0u; cnt = 0u; mine = 0u;
#pragma unroll
        for (unsigned j = 0; j < 16; ++j) { const unsigned c = xb_ld(&bar[XB_XCNT(j)]); sum += c; cnt += (c > 0u) ? 1u : 0u; mine = (j == x) ? c : mine; }
        if (sum == G) break;
        __builtin_amdgcn_s_sleep(1);
        if ((++sp & 255u) == 0u) { if (xb_ld(&bar[XB_TMO])) break; if (sp > XB_SPIN_CAP) { atomicAdd(&bar[XB_TMO], 1u); break; } }
    }
    nloc = mine > 0u ? mine : 1u; nx = cnt > 0u ? cnt : 1u;
}
__device__ __forceinline__ void xcd_barrier(const XcdBarrier& b) {
    asm volatile("s_waitcnt vmcnt(0)" ::: "memory");
    __syncthreads();
    if (threadIdx.x == 0) {
        unsigned* bar = b.bar;
        __builtin_amdgcn_s_waitcnt(0);
        unsigned nloc = b.st[0], nx = b.st[1];
        if (nloc == 0u) { xcd_barrier_complete(bar, b.x, nloc, nx); b.st[0] = nloc; b.st[1] = nx; }
        const unsigned old = xb_add(&bar[XB_XSUB(b.x)], 1u);
        const unsigned gen = old / nloc;
        if (old + 1u == (gen + 1u) * nloc) {
            __builtin_amdgcn_fence(__ATOMIC_RELEASE, "agent");
            asm volatile("s_waitcnt vmcnt(0)" ::: "memory");
            const unsigned og = xb_add(&bar[XB_TOP], 1u);
            const unsigned tg = og / nx;
            if (og + 1u == (tg + 1u) * nx) xb_add(&bar[XB_TOPGEN], 1u);
            else XB_SPIN(xb_ld(&bar[XB_TOPGEN]) == tg, bar);
            __builtin_amdgcn_fence(__ATOMIC_ACQUIRE, "agent");
            xb_add(&bar[XB_XGEN(b.x)], 1u);
            asm volatile("s_waitcnt vmcnt(0)" ::: "memory");
        } else {
            XB_SPIN(xb_ld(&bar[XB_XGEN(b.x)]) == gen, bar);
            __builtin_amdgcn_fence(__ATOMIC_ACQUIRE, "agent");
            asm volatile("s_waitcnt vmcnt(0)" ::: "memory");
        }
    }
    __syncthreads();
}

namespace pg8 {
constexpr int BM = 256, BK = 64, HALF = 128, HTB = HALF * BK * 2, STAGE_BYTES = 8 * HTB, NXCD = 8, WGM = 8;
__device__ __forceinline__ int lds_byte(int r, int c) { const int st = (r >> 4) * 2 + (c >> 5), rr = r & 15, cc = c & 31, ob = rr * 64 + cc * 2; return st * 1024 + (ob ^ (((ob >> 9) & 1) << 5)); }
__device__ __forceinline__ void stage_rc(int b, int& R, int& C) { const int st = b / 1024, sb = b % 1024, swz = sb ^ (((sb >> 9) & 1) << 5); R = (st >> 1) * 16 + swz / 64; C = (st & 1) * 32 + (swz % 64) / 2; }
__device__ __forceinline__ int perm32(int rho) { const int n = rho >> 4, i = rho & 15; return 8 * (i >> 2) + 4 * n + (i & 3); }

struct Unit { int pm, pn, z; size_t aoff, boff; };
struct Gemm { const bf16_t* A; const bf16_t* Bt; int lda, ldb, K; };

struct TileOrder {
    int nM, nN, nwg, G, c;
    __device__ void init(int M, int N, int G_, int c_) { nM = M / BM; nN = N / BM; nwg = nM * nN; G = G_; c = c_; }
    __device__ bool tile(long L, int& pm, int& pn) const {
        if (L >= nwg) return false;
        int wgid = (int)L; { const int q = nwg / NXCD, r = nwg % NXCD, xcd = wgid % NXCD, off = wgid / NXCD; wgid = (xcd < r ? xcd * (q + 1) : r * (q + 1) + (xcd - r) * q) + off; }
        const int nig = WGM * nN, gid = wgid / nig, fm = gid * WGM, gsz = (nM - fm) < WGM ? (nM - fm) : WGM;
        pm = fm + ((wgid % nig) % gsz); pn = (wgid % nig) / gsz; return true;
    }
};
struct PlainOrder : TileOrder {
    int lda, ldb;
    __device__ bool next(int i, Unit& u) const { if (!tile((long)i * G + c, u.pm, u.pn)) return false; u.z = 0; u.aoff = (size_t)u.pm * BM * lda; u.boff = (size_t)u.pn * BM * ldb; return true; }
};
struct PoolOrder : TileOrder {
    __device__ bool next(int i, Unit& u) const { if (!tile((long)i * G + c, u.pm, u.pn)) return false; u.z = 0; u.aoff = (size_t)u.pm * BM * 1024 + (size_t)u.pn * 256; u.boff = (size_t)u.pn * 256 * 256; return true; }
};
struct MergeOrder : TileOrder {
    __device__ bool next(int i, Unit& u) const { if (!tile((long)(i >> 2) * G + c, u.pm, u.pn)) return false; u.z = i & 3;
        u.aoff = (size_t)u.z * NTOK * 1024 + (size_t)u.pm * BM * 1024; u.boff = (size_t)u.z * 2048 * 1024 + (size_t)u.pn * BM * 1024; return true; }
};

template <class Epi, class Sched>
__device__ __forceinline__ void gemm_phase(LAS unsigned char* lds, const Gemm g, const Sched& S, const Epi& E) {
    const int tid = otid(), wid = __builtin_amdgcn_readfirstlane(tid >> 6), lane = tid & 63, wr = wid >> 2, wc = wid & 3, fr = lane & 15, fq = lane >> 4;
    const int K = g.K, nt = K / BK;
    unsigned voffA[2], voffB[2];
#pragma unroll
    for (int i = 0; i < 2; ++i) { int R, C; stage_rc(tid * 16 + i * 8192, R, C); const int Rb = Epi::PERM ? ((R & ~31) + perm32(R & 31)) : R;
        voffA[i] = (unsigned)(R * g.lda + C) * 2u; voffB[i] = (unsigned)(Rb * g.ldb + C) * 2u; }
    const size_t kstep = (size_t)(BK * 2);
    const size_t hstepA = (size_t)HALF * g.lda * 2, hstepB = (size_t)HALF * g.ldb * 2;
    const unsigned ldsw = (unsigned)wid * 1024u;
    const int aoff = lds_byte(wr * 64 + fr, fq * 8), boff = lds_byte(wc * 32 + fr, fq * 8);
#define PG8_SA(b, h) (((b) * 2 + (h)) * HTB)
#define PG8_SB(b, h) ((4 + (b) * 2 + (h)) * HTB)
#define PG8_STAGE(bufoff, gbase, voff) do { _Pragma("unroll") for (int _i = 0; _i < 2; ++_i) \
        __builtin_amdgcn_global_load_lds((const unsigned*)((const char*)(gbase) + (voff)[_i]), (LAS unsigned*)(lds + (bufoff) + ldsw + _i * 8192), 16, 0, 0); } while (0)
#define PG8_LDA(dst, b, h) do { _Pragma("unroll") for (int m = 0; m < 4; ++m) _Pragma("unroll") for (int k = 0; k < 2; ++k) dst[m][k] = *(const LAS bf16x8*)(lds + PG8_SA(b, h) + aoff + m * 2048 + k * 1024); } while (0)
#define PG8_LDB(dst, b, h) do { _Pragma("unroll") for (int n = 0; n < 2; ++n) _Pragma("unroll") for (int k = 0; k < 2; ++k) dst[n][k] = *(const LAS bf16x8*)(lds + PG8_SB(b, h) + boff + n * 2048 + k * 1024); } while (0)
#define PG8_MMA(ai, bj, At, Bt) do { __builtin_amdgcn_s_setprio(1); _Pragma("unroll") for (int m = 0; m < 4; ++m) _Pragma("unroll") for (int n = 0; n < 2; ++n) _Pragma("unroll") for (int k = 0; k < 2; ++k) \
        acc[ai][bj][m][n] = __builtin_amdgcn_mfma_f32_16x16x32_bf16(Bt[n][k], At[m][k], acc[ai][bj][m][n], 0, 0, 0); __builtin_amdgcn_s_setprio(0); } while (0)
#define PG8_WAIT_V(n) asm volatile("s_waitcnt vmcnt(" #n ")" ::: "memory")
#define PG8_WAIT_L(n) asm volatile("s_waitcnt lgkmcnt(" #n ")" ::: "memory")
#define PG8_BAR __builtin_amdgcn_s_barrier()
#define PG8_SCHED __builtin_amdgcn_sched_barrier(0)
    Unit cur, nxt; int ui = 0;
    if (!S.next(0, cur)) return;
    f32x4 acc[2][2][4][2];
#pragma unroll
    for (int a = 0; a < 2; ++a)
#pragma unroll
        for (int b = 0; b < 2; ++b)
#pragma unroll
            for (int m = 0; m < 4; ++m)
#pragma unroll
                for (int n = 0; n < 2; ++n) acc[a][b][m][n] = (f32x4){0.f, 0.f, 0.f, 0.f};
    bf16x8 At[4][2], B0[2][2], B1[2][2];
    const char* cA = (const char*)g.A + cur.aoff * 2; const char* cB = (const char*)g.Bt + cur.boff * 2;
    PG8_STAGE(PG8_SB(0, 0), cB, voffB); PG8_STAGE(PG8_SA(0, 0), cA, voffA); PG8_STAGE(PG8_SB(0, 1), cB + hstepB, voffB); PG8_STAGE(PG8_SA(0, 1), cA + hstepA, voffA);
    if (wr == 1) PG8_BAR;
    PG8_WAIT_V(4); PG8_BAR;
    PG8_STAGE(PG8_SB(1, 0), cB + kstep, voffB); PG8_STAGE(PG8_SA(1, 0), cA + kstep, voffA); PG8_STAGE(PG8_SB(1, 1), cB + hstepB + kstep, voffB);
    PG8_WAIT_V(6); PG8_BAR;
    for (;;) {
        const bool has_next = S.next(ui + 1, nxt);
        const char* nA = has_next ? (const char*)g.A + nxt.aoff * 2 : cA; const char* nB = has_next ? (const char*)g.Bt + nxt.boff * 2 : cB;
        for (int t = 0; t < nt; t += 2) {
            const bool last = (t == nt - 2);
            const char* a1 = cA + (size_t)(t + 1) * kstep;
            const char* a2 = last ? nA : cA + (size_t)(t + 2) * kstep; const char* b2 = last ? nB : cB + (size_t)(t + 2) * kstep;
            const char* a3 = a2 + kstep; const char* b3 = b2 + kstep;
            PG8_LDB(B0, 0, 0); PG8_SCHED; PG8_LDA(At, 0, 0); PG8_STAGE(PG8_SA(1, 1), a1 + hstepA, voffA);
            PG8_WAIT_L(8); PG8_BAR; PG8_WAIT_L(0); PG8_MMA(0, 0, At, B0); PG8_BAR; PG8_SCHED;
            PG8_LDB(B1, 0, 1); PG8_STAGE(PG8_SB(0, 0), b2, voffB);
            PG8_BAR; PG8_WAIT_L(0); PG8_MMA(0, 1, At, B1); PG8_BAR;
            PG8_LDA(At, 0, 1); PG8_STAGE(PG8_SA(0, 0), a2, voffA);
            PG8_BAR; PG8_WAIT_L(0); PG8_MMA(1, 0, At, B0); PG8_BAR; PG8_SCHED;
            PG8_STAGE(PG8_SB(0, 1), b2 + hstepB, voffB);
            PG8_WAIT_V(6); PG8_BAR; PG8_MMA(1, 1, At, B1); PG8_BAR;
            PG8_LDB(B0, 1, 0); PG8_SCHED; PG8_LDA(At, 1, 0); PG8_STAGE(PG8_SA(0, 1), a2 + hstepA, voffA);
            PG8_WAIT_L(8); PG8_BAR; PG8_WAIT_L(0); PG8_MMA(0, 0, At, B0); PG8_BAR; PG8_SCHED;
            PG8_LDB(B1, 1, 1); PG8_STAGE(PG8_SB(1, 0), b3, voffB);
            PG8_BAR; PG8_WAIT_L(0); PG8_MMA(0, 1, At, B1); PG8_BAR;
            PG8_LDA(At, 1, 1); PG8_STAGE(PG8_SA(1, 0), a3, voffA);
            PG8_BAR; PG8_WAIT_L(0); PG8_MMA(1, 0, At, B0); PG8_BAR; PG8_SCHED;
            PG8_STAGE(PG8_SB(1, 1), b3 + hstepB, voffB);
            PG8_WAIT_V(6); PG8_BAR; PG8_MMA(1, 1, At, B1); PG8_BAR;
        }
        const bool keep = E(acc, cur, wr, wc, fr, fq);
        if (!has_next) break;
        if (!keep) {
#pragma unroll
            for (int a = 0; a < 2; ++a)
#pragma unroll
                for (int b = 0; b < 2; ++b)
#pragma unroll
                    for (int m = 0; m < 4; ++m)
#pragma unroll
                        for (int n = 0; n < 2; ++n) acc[a][b][m][n] = (f32x4){0.f, 0.f, 0.f, 0.f};
        }
        cur = nxt; cA = nA; cB = nB; ++ui;
    }
    PG8_WAIT_V(0);
    if (wr == 0) PG8_BAR;
    PG8_BAR;
#undef PG8_SA
#undef PG8_SB
#undef PG8_STAGE
#undef PG8_LDA
#undef PG8_LDB
#undef PG8_MMA
#undef PG8_WAIT_V
#undef PG8_WAIT_L
#undef PG8_BAR
#undef PG8_SCHED
}

struct EpiIn {
    static constexpr bool PERM = true;
    bf16_t* U; float* dtraw; float* out; int layer;
    __device__ __forceinline__ bool operator()(f32x4 (&acc)[2][2][4][2], const Unit& u, int wr, int wc, int fr, int fq) const {
        const int rl0 = wr * 64 + fr, cl0 = wc * 32 + 8 * fq, pn = u.pn;
        const bool gate = pn >= 32;
        float* cb = nullptr; int cld = 0;
        if (u.pm < 32) {
            if (pn == 8)  { cb = out + O_CBK + (size_t)(u.pm * 4 + layer) * 256 * 256; cld = 256; }
            else if (pn == 9)  { cb = out + O_CBV + (size_t)(u.pm * 4 + layer) * 256 * 256; cld = 256; }
            else if (pn >= 14 && pn < 18) { cb = out + O_CCK + (size_t)(u.pm * 4 + layer) * 256 * 1024 + (pn - 14) * 256; cld = 1024; }
            else if (pn >= 18 && pn < 22) { cb = out + O_CCV + (size_t)(u.pm * 4 + layer) * 256 * 1024 + (pn - 18) * 256; cld = 1024; }
        }
#pragma unroll
        for (int ai = 0; ai < 2; ++ai)
#pragma unroll
            for (int m = 0; m < 4; ++m) {
                const int rl = rl0 + ai * HALF + m * 16;
                bf16_t* rowp = U + (size_t)(u.pm * BM + rl) * ULD + pn * BM + cl0;
#pragma unroll
                for (int bj = 0; bj < 2; ++bj) {
                    f32x4 v0 = acc[ai][bj][m][0], v1 = acc[ai][bj][m][1];
                    if (cb) { float* cp = cb + (size_t)rl * cld + cl0 + bj * HALF; *(f32x4*)cp = v0; *(f32x4*)(cp + 4) = v1; }
                    if (pn == 31 && wc == 0 && bj == 0) { float* dp = dtraw + (size_t)(u.pm * BM + rl) * 32 + 8 * fq; *(f32x4*)dp = v0; *(f32x4*)(dp + 4) = v1; }
                    if (gate) {
#pragma unroll
                        for (int j = 0; j < 4; ++j) { v0[j] = fmaxf(sigmoid_f(v0[j]), 1e-30f); v1[j] = fmaxf(sigmoid_f(v1[j]), 1e-30f); }
                    }
                    u32x4 w; w.x = pk2(v0[0], v0[1]); w.y = pk2(v0[2], v0[3]); w.z = pk2(v1[0], v1[1]); w.w = pk2(v1[2], v1[3]);
                    *(u32x4*)(rowp + bj * HALF) = w;
                }
            }
        return false;
    }
};
template <int ACT> struct EpiBf16 {
    static constexpr bool PERM = true;
    bf16_t* O; int ldc;
    __device__ __forceinline__ bool operator()(f32x4 (&acc)[2][2][4][2], const Unit& u, int wr, int wc, int fr, int fq) const {
        const int row0 = u.pm * BM + wr * 64 + fr, col0 = u.pn * BM + wc * 32 + 8 * fq;
#pragma unroll
        for (int ai = 0; ai < 2; ++ai)
#pragma unroll
            for (int m = 0; m < 4; ++m) {
                bf16_t* rowp = O + (size_t)(row0 + ai * HALF + m * 16) * ldc + col0;
#pragma unroll
                for (int bj = 0; bj < 2; ++bj) {
                    f32x4 v0 = acc[ai][bj][m][0], v1 = acc[ai][bj][m][1];
                    if (ACT == 1) {
#pragma unroll
                        for (int j = 0; j < 4; ++j) { const float a = fmaxf(v0[j], 0.f), b = fmaxf(v1[j], 0.f); v0[j] = a * a; v1[j] = b * b; }
                    }
                    u32x4 w; w.x = pk2(v0[0], v0[1]); w.y = pk2(v0[2], v0[3]); w.z = pk2(v1[0], v1[1]); w.w = pk2(v1[2], v1[3]);
                    *(u32x4*)(rowp + bj * HALF) = w;
                }
            }
        return false;
    }
};
struct EpiMerge {
    static constexpr bool PERM = true;
    const bf16_t* U; const float* ssq; bf16_t* O;
    __device__ __forceinline__ bool operator()(f32x4 (&acc)[2][2][4][2], const Unit& u, int wr, int wc, int fr, int fq) const {
        const int row0 = u.pm * BM + wr * 64 + fr, col0 = u.pn * BM + wc * 32 + 8 * fq, z = u.z;
#pragma unroll
        for (int ai = 0; ai < 2; ++ai)
#pragma unroll
            for (int m = 0; m < 4; ++m) {
                const int row = row0 + ai * HALF + m * 16;
                float rstd = 1.0f;
                if (z >= 2) { const f32x4* sp = (const f32x4*)(ssq + (size_t)row * 16); const f32x4 a = sp[0], b = sp[1], c = sp[2], d = sp[3];
                    const float s = ((a[0] + a[1]) + (a[2] + a[3])) + ((b[0] + b[1]) + (b[2] + b[3])) + ((c[0] + c[1]) + (c[2] + c[3])) + ((d[0] + d[1]) + (d[2] + d[3]));
                    rstd = 1.0f / sqrtf(s * (1.0f / 1024.0f) + RMS_EPS); }
                const bf16_t* gp = U + (size_t)row * ULD + C_GATE + col0;
#pragma unroll
                for (int bj = 0; bj < 2; ++bj) {
                    const u32x4 gz = *(const u32x4*)(gp + z * 2048 + bj * HALF);
                    float f[8];
                    if (z < 3) {
                        const u32x4 gn = *(const u32x4*)(gp + (z + 1) * 2048 + bj * HALF);
                        const float rn = (z == 2) ? rstd : 1.0f;
                        f[0] = bflo(gz.x) / (bflo(gn.x) * rn); f[1] = bfhi(gz.x) / (bfhi(gn.x) * rn); f[2] = bflo(gz.y) / (bflo(gn.y) * rn); f[3] = bfhi(gz.y) / (bfhi(gn.y) * rn);
                        f[4] = bflo(gz.z) / (bflo(gn.z) * rn); f[5] = bfhi(gz.z) / (bfhi(gn.z) * rn); f[6] = bflo(gz.w) / (bflo(gn.w) * rn); f[7] = bfhi(gz.w) / (bfhi(gn.w) * rn);
                    } else {
                        f[0] = bflo(gz.x) * rstd; f[1] = bfhi(gz.x) * rstd; f[2] = bflo(gz.y) * rstd; f[3] = bfhi(gz.y) * rstd;
                        f[4] = bflo(gz.z) * rstd; f[5] = bfhi(gz.z) * rstd; f[6] = bflo(gz.w) * rstd; f[7] = bfhi(gz.w) * rstd;
                    }
                    f32x4 v0 = acc[ai][bj][m][0], v1 = acc[ai][bj][m][1];
#pragma unroll
                    for (int j = 0; j < 4; ++j) { v0[j] *= f[j]; v1[j] *= f[4 + j]; }
                    if (z < 3) { acc[ai][bj][m][0] = v0; acc[ai][bj][m][1] = v1; }
                    else { u32x4 w; w.x = pk2(v0[0], v0[1]); w.y = pk2(v0[2], v0[3]); w.z = pk2(v1[0], v1[1]); w.w = pk2(v1[2], v1[3]);
                        *(u32x4*)(O + (size_t)row * D + col0 + bj * HALF) = w; }
                }
            }
        return z < 3;
    }
};
struct EpiRes {
    static constexpr bool PERM = false;
    const float* xres; const float* modl; int gi; float* pre;
    __device__ __forceinline__ bool operator()(f32x4 (&acc)[2][2][4][2], const Unit& u, int wr, int wc, int fr, int fq) const {
        const int row0 = u.pm * BM + wr * 64 + fr, col0 = u.pn * BM + wc * 32 + 4 * fq;
        const float* gv = modl + (size_t)mod_index(u.pm * BM) * 12288 + gi * 2048 + col0;
        f32x4 gt[2][2];
#pragma unroll
        for (int bj = 0; bj < 2; ++bj)
#pragma unroll
            for (int n = 0; n < 2; ++n) gt[bj][n] = *(const f32x4*)(gv + bj * HALF + n * 16);
#pragma unroll
        for (int ai = 0; ai < 2; ++ai)
#pragma unroll
            for (int m = 0; m < 4; ++m) {
                const size_t off = (size_t)(row0 + ai * HALF + m * 16) * D + col0;
#pragma unroll
                for (int bj = 0; bj < 2; ++bj)
#pragma unroll
                    for (int n = 0; n < 2; ++n) { const f32x4 xv = *(const f32x4*)(xres + off + bj * HALF + n * 16);
                        *(f32x4*)(pre + off + bj * HALF + n * 16) = xv * ALPHA + gt[bj][n] * acc[ai][bj][m][n]; }
                asm volatile("" ::: "memory");
            }
        return false;
    }
};
}

template <int MODE>
__device__ __forceinline__ void convT_tile(const float* src, size_t lds_src, int k0, int n0, const float* scl, bf16_t* dst, size_t ldd, LAS float* tile) {
    const int tid = otid();
#pragma unroll
    for (int it = 0; it < 2; ++it) {
        const int kk = (tid >> 4) + 32 * it, nn = (tid & 15) * 4, n = n0 + nn;
        int sc = n;
        if (MODE == 1) sc = n < 7968 ? n : (n < 8192 ? -1 : n - 224);
        f32x4 v = (f32x4){0.f, 0.f, 0.f, 0.f};
        if (sc >= 0) v = *(const f32x4*)(src + (size_t)(k0 + kk) * lds_src + sc);
        if (scl) v *= scl[k0 + kk];
        LAS float* t = tile + kk * 65 + nn;
        t[0] = v[0]; t[1] = v[1]; t[2] = v[2]; t[3] = v[3];
    }
    __syncthreads();
    {
        const int n = tid >> 3, k8 = (tid & 7) * 8;
        const LAS float* t = tile + k8 * 65 + n;
        u32x4 w; w.x = pk2(t[0], t[65]); w.y = pk2(t[130], t[195]); w.z = pk2(t[260], t[325]); w.w = pk2(t[390], t[455]);
        *(u32x4*)(dst + (size_t)(n0 + n) * ldd + k0 + k8) = w;
    }
    __syncthreads();
}
template <int MODE>
__device__ __forceinline__ void convT_job(const float* src, size_t lds_src, int K, int N, const float* scl, bf16_t* dst, size_t ldd, LAS float* tile) {
    const int tk = K / 64, tn = N / 64;
    for (int t = obid(); t < tk * tn; t += gridDim.x) convT_tile<MODE>(src, lds_src, (t % tk) * 64, (t / tk) * 64, scl, dst, ldd, tile);
}

__device__ __forceinline__ void phase_pro0(const Params& p, unsigned char* lds_g) {
    LAS unsigned char* lds = (LAS unsigned char*)lds_g;
    const int tid = otid(), lane = tid & 63, wave = tid >> 6, G = gridDim.x;
    unsigned char* ws = p.ws;
    if (obid() < 192) {
        LAS float* sl = (LAS float*)lds;
        LAS float* red = (LAS float*)(lds + 73728);
        for (int i = tid; i < 9 * 2048; i += 512) { const int j = i >> 11, k = i & 2047; const float v = j == 0 ? p.c_ctx[k] : p.c[(j - 1) * 2048 + k]; sl[i] = silu_f(v); }
        __syncthreads();
        float* mod = (float*)(ws + WS_MOD);
        for (int un = obid(); un < 192; un += G) {
            const int l = un / 48, col = (un % 48) * 256 + lane * 4;
            f32x4 a[9];
#pragma unroll
            for (int j = 0; j < 9; ++j) a[j] = (f32x4){0.f, 0.f, 0.f, 0.f};
            const float* wp = p.w_ada + ((size_t)l * 2048 + wave * 256) * 12288 + col;
            for (int k = 0; k < 256; k += 4) {
                f32x4 w[4];
#pragma unroll
                for (int q = 0; q < 4; ++q) w[q] = *(const f32x4*)(wp + (size_t)(k + q) * 12288);
#pragma unroll
                for (int q = 0; q < 4; ++q)
#pragma unroll
                    for (int j = 0; j < 9; ++j) a[j] += w[q] * sl[j * 2048 + wave * 256 + k + q];
            }
            if (wave >= 4) {
#pragma unroll
                for (int j = 0; j < 9; ++j) { LAS float* r = red + ((wave - 4) * 9 + j) * 256 + lane * 4; r[0] = a[j][0]; r[1] = a[j][1]; r[2] = a[j][2]; r[3] = a[j][3]; }
            }
            __syncthreads();
            if (wave < 4) {
#pragma unroll
                for (int j = 0; j < 9; ++j) { LAS float* r = red + (wave * 9 + j) * 256 + lane * 4; r[0] += a[j][0]; r[1] += a[j][1]; r[2] += a[j][2]; r[3] += a[j][3]; }
            }
            __syncthreads();
            for (int i = tid; i < 9 * 256; i += 512) { const int j = i >> 8, cc = i & 255;
                const float s = (red[(0 * 9 + j) * 256 + cc] + red[(1 * 9 + j) * 256 + cc]) + (red[(2 * 9 + j) * 256 + cc] + red[(3 * 9 + j) * 256 + cc]);
                const int n = (un % 48) * 256 + cc;
                mod[((size_t)l * 9 + j) * 12288 + n] = s + p.b_ada[(size_t)l * 12288 + n]; }
            __syncthreads();
        }
    }
    __syncthreads();
    LAS float* tile = (LAS float*)lds;
    for (int l = 0; l < DEPTH; ++l) {
        convT_job<1>(p.w_in + (size_t)l * 2048 * DIN, DIN, 2048, 16384, nullptr, (bf16_t*)(ws + WS_WIN) + (size_t)l * 16384 * 2048, 2048, tile);
        for (int gq = 0; gq < 4; ++gq)
            convT_job<0>(p.w_pool + ((size_t)l * 4 + gq) * 256 * 256, 256, 256, 256, nullptr, (bf16_t*)(ws + WS_WPOOL) + ((size_t)l * 4 + gq) * 256 * 256, 256, tile);
        for (int z = 0; z < 4; ++z) {
            const float* scl = z == 0 ? p.pool_scale + l * 1024 : (z == 3 ? p.ssm_norm + l * 1024 : nullptr);
            convT_job<0>(p.w_branch + ((size_t)l * 4 + z) * 1024 * 2048, 2048, 1024, 2048, scl, (bf16_t*)(ws + WS_WB) + ((size_t)l * 4 + z) * 2048 * 1024, 1024, tile);
        }
        convT_job<0>(p.w_o + (size_t)l * 2048 * 2048, 2048, 2048, 2048, nullptr, (bf16_t*)(ws + WS_WO) + (size_t)l * 2048 * 2048, 2048, tile);
        convT_job<0>(p.w_mlp1 + (size_t)l * 2048 * 8192, 8192, 2048, 8192, nullptr, (bf16_t*)(ws + WS_W1) + (size_t)l * 8192 * 2048, 2048, tile);
        convT_job<0>(p.w_mlp2 + (size_t)l * 8192 * 2048, 2048, 8192, 2048, nullptr, (bf16_t*)(ws + WS_W2) + (size_t)l * 2048 * 8192, 8192, tile);
    }
    {
        const size_t gt = (size_t)obid() * 512 + tid, gs = (size_t)G * 512;
        bf16_t* ckb = (bf16_t*)(ws + WS_CKB); bf16_t* ckc = (bf16_t*)(ws + WS_CKC);
        for (size_t i = gt; i < (size_t)8 * 4 * 256 * 256 / 4; i += gs) { const f32x4 v = *(const f32x4*)(p.cache_b_k + i * 4); u32x2 w; w.x = pk2(v[0], v[1]); w.y = pk2(v[2], v[3]); *(u32x2*)(ckb + i * 4) = w; }
        for (size_t i = gt; i < (size_t)8 * 4 * 256 * 1024 / 4; i += gs) { const f32x4 v = *(const f32x4*)(p.cache_c_k + i * 4); u32x2 w; w.x = pk2(v[0], v[1]); w.y = pk2(v[2], v[3]); *(u32x2*)(ckc + i * 4) = w; }
        for (int t = obid(); t < 32 * 2 * 8; t += G) {
            const int bl = t / 16, hh = (t / 8) % 2, tt = t % 8;
            convT_tile<0>(p.cache_b_v + (size_t)bl * 256 * 256 + hh * 128, 256, (tt % 4) * 64, (tt / 4) * 64, nullptr, (bf16_t*)(ws + WS_CVTB) + ((size_t)bl * 2 + hh) * 128 * 256, 256, tile);
        }
        for (int t = obid(); t < 32 * 8 * 8; t += G) {
            const int bl = t / 64, hh = (t / 8) % 8, tt = t % 8;
            convT_tile<0>(p.cache_c_v + (size_t)bl * 256 * 1024 + hh * 128, 1024, (tt % 4) * 64, (tt / 4) * 64, nullptr, (bf16_t*)(ws + WS_CVTC) + ((size_t)bl * 8 + hh) * 128 * 256, 256, tile);
        }
    }
}

__device__ __forceinline__ void phase_pro1(const Params& p) {
    const int lane = otid() & 63, gw = obid() * 8 + (otid() >> 6), nw = gridDim.x * 8;
    const float* mod = (const float*)(p.ws + WS_MOD);
    bf16_t* H = (bf16_t*)(p.ws + WS_H);
    for (int row = gw; row < NTOK; row += nw) {
        const float* src = row < NCTX ? p.x_prompt + (size_t)row * D : p.x_sample + (size_t)(row - NCTX) * D;
        const float* mv = mod + (size_t)mod_index(row) * 12288;
#pragma unroll
        for (int i = 0; i < 8; ++i) { const int c = i * 256 + lane * 4; const f32x4 v = *(const f32x4*)(src + c);
            *(f32x4*)(p.out + (size_t)row * D + c) = v;
            const f32x4 sh = *(const f32x4*)(mv + c), sc = *(const f32x4*)(mv + 2048 + c); const f32x4 h = v * (sc + 1.0f) + sh;
            u32x2 w; w.x = pk2(h[0], h[1]); w.y = pk2(h[2], h[3]); *(u32x2*)(H + (size_t)row * D + c) = w; }
    }
}

__device__ __forceinline__ void phase_ln(const Params& p, const float* g, const float* b, const float* modn  , int si  ) {
    const int lane = otid() & 63, gw = obid() * 8 + (otid() >> 6), nw = gridDim.x * 8;
    const float* pre = (const float*)(p.ws + WS_PRE);
    bf16_t* H = (bf16_t*)(p.ws + WS_H);
    for (int row = gw; row < NTOK; row += nw) {
        f32x4 v[8]; float s = 0.f;
#pragma unroll
        for (int i = 0; i < 8; ++i) { v[i] = *(const f32x4*)(pre + (size_t)row * D + i * 256 + lane * 4); s += (v[i][0] + v[i][1]) + (v[i][2] + v[i][3]); }
#pragma unroll
        for (int o = 32; o >= 1; o >>= 1) s += __shfl_xor(s, o);
        const float mu = s * (1.0f / 2048.0f); float q = 0.f;
#pragma unroll
        for (int i = 0; i < 8; ++i) { const f32x4 d = v[i] - mu; q += (d[0] * d[0] + d[1] * d[1]) + (d[2] * d[2] + d[3] * d[3]); }
#pragma unroll
        for (int o = 32; o >= 1; o >>= 1) q += __shfl_xor(q, o);
        const float rstd = 1.0f / sqrtf(q * (1.0f / 2048.0f) + LN_EPS);
        const float* mv = modn ? modn + (size_t)mod_index(row) * 12288 + si * 2048 : nullptr;
#pragma unroll
        for (int i = 0; i < 8; ++i) { const int c = i * 256 + lane * 4;
            const f32x4 x = (v[i] - mu) * rstd * *(const f32x4*)(g + c) + *(const f32x4*)(b + c);
            *(f32x4*)(p.out + (size_t)row * D + c) = x;
            if (mv) { const f32x4 sh = *(const f32x4*)(mv + c), sc = *(const f32x4*)(mv + 2048 + c); const f32x4 h = x * (sc + 1.0f) + sh;
                u32x2 w; w.x = pk2(h[0], h[1]); w.y = pk2(h[2], h[3]); *(u32x2*)(H + (size_t)row * D + c) = w; }
        }
    }
}

__device__ __forceinline__ void phase_premix(const Params& p, int l, unsigned char* lds_g) {
    const int tid = otid(), G = gridDim.x;
    const size_t gt = (size_t)obid() * 512 + tid, gs = (size_t)G * 512;
    unsigned char* ws = p.ws;
    bf16_t* U = (bf16_t*)(ws + WS_U);
    {
        bf16_t* P = (bf16_t*)(ws + WS_POOLED);
        for (size_t it = gt; it < (size_t)NTOK * 128; it += gs) {
            const int row = (int)(it >> 7), c8 = (int)(it & 127) * 8, gq = c8 >> 8, w = 2 << gq;
            const int L = row < NCTX ? 256 : 1024, s = row < NCTX ? (row & 255) : ((row - NCTX) & 1023);
            int lo = s - (w >> 1), hi = s + (w >> 1); lo = lo < 0 ? 0 : lo; hi = hi > L ? L : hi;
            float a[8];
#pragma unroll
            for (int j = 0; j < 8; ++j) a[j] = 0.f;
            const bf16_t* base = U + (size_t)(row - s) * ULD + C_POOL + c8;
            for (int j = lo; j < hi; ++j) { const u32x4 v = *(const u32x4*)(base + (size_t)j * ULD);
                a[0] += bflo(v.x); a[1] += bfhi(v.x); a[2] += bflo(v.y); a[3] += bfhi(v.y); a[4] += bflo(v.z); a[5] += bfhi(v.z); a[6] += bflo(v.w); a[7] += bfhi(v.w); }
            const float inv = 1.0f / (float)(hi - lo);
            const u32x4 v = *(const u32x4*)(base + (size_t)s * ULD);
            u32x4 o; o.x = pk2(a[0] * inv - bflo(v.x), a[1] * inv - bfhi(v.x)); o.y = pk2(a[2] * inv - bflo(v.y), a[3] * inv - bfhi(v.y));
            o.z = pk2(a[4] * inv - bflo(v.z), a[5] * inv - bfhi(v.z)); o.w = pk2(a[6] * inv - bflo(v.w), a[7] * inv - bfhi(v.w));
            *(u32x4*)(P + (size_t)row * 1024 + c8) = o;
        }
    }
    {
        float* X = (float*)(ws + WS_XACT);
        const float* cw = p.conv_w + (size_t)l * 5 * 1280; const float* cbias = p.conv_b + (size_t)l * 1280;
        for (size_t it = gt; it < (size_t)NTOK * 160; it += gs) {
            const int row = (int)(it / 160), c8 = (int)(it % 160) * 8;
            const int L = row < NCTX ? 256 : 1024, s = row < NCTX ? (row & 255) : ((row - NCTX) & 1023);
            float a[8];
#pragma unroll
            for (int j = 0; j < 8; ++j) a[j] = cbias[c8 + j];
#pragma unroll
            for (int k = 0; k < 5; ++k) { const int sj = s + k - 2; if (sj < 0 || sj >= L) continue;
                const u32x4 v = *(const u32x4*)(U + (size_t)(row + k - 2) * ULD + C_XBC + c8);
                const f32x4 w0 = *(const f32x4*)(cw + k * 1280 + c8), w1 = *(const f32x4*)(cw + k * 1280 + c8 + 4);
                a[0] += bflo(v.x) * w0[0]; a[1] += bfhi(v.x) * w0[1]; a[2] += bflo(v.y) * w0[2]; a[3] += bfhi(v.y) * w0[3];
                a[4] += bflo(v.z) * w1[0]; a[5] += bfhi(v.z) * w1[1]; a[6] += bflo(v.w) * w1[2]; a[7] += bfhi(v.w) * w1[3]; }
            f32x4 o0, o1;
#pragma unroll
            for (int j = 0; j < 4; ++j) { o0[j] = silu_f(a[j]); o1[j] = silu_f(a[4 + j]); }
            *(f32x4*)(X + (size_t)row * 1280 + c8) = o0; *(f32x4*)(X + (size_t)row * 1280 + c8 + 4) = o1;
        }
    }
    {
        const float* raw = (const float*)(ws + WS_DTRAW); float* DT = (float*)(ws + WS_DT); float* DEC = (float*)(ws + WS_DEC);
        for (size_t it = gt; it < (size_t)NTOK * 32; it += gs) { const int j = (int)(it & 31);
            const float x = raw[it] + p.dt_bias[l * 32 + j]; const float dt = x > 20.f ? x : log1pf(expf(x));
            const float a = -expf(p.a_log[l * 32 + j]);
            DT[it] = dt; DEC[it] = expf(dt * a); }
    }
    {
        for (size_t it = gt; it < (size_t)8192 * 10 * 64; it += gs) {
            const int t = (int)(it / 640), rem = (int)(it % 640), hd = rem >> 6, pi = rem & 63, half = pi >> 5, i = pi & 31;
            const int tt = t & 1023; const float pos = (float)(half == 0 ? (tt >> 6) : (tt & 63));
            const float freq = powf(10000.0f, -(float)i * (1.0f / 32.0f)); float sn, cs; sincosf(pos * freq, &sn, &cs);
            bf16_t* q = U + (size_t)(NCTX + t) * ULD + (hd < 8 ? C_QB + hd * 128 : C_KB + (hd - 8) * 128) + half * 64 + i;
            const float x1 = bf2f(q[0]), x2 = bf2f(q[32]);
            const unsigned w = pk2(x1 * cs - x2 * sn, x1 * sn + x2 * cs);
            q[0] = (bf16_t)(w & 0xffff); q[32] = (bf16_t)(w >> 16);
        }
    }
    {
        bf16_t* tb = (bf16_t*)lds_g;
        bf16_t* VTB = (bf16_t*)(ws + WS_VTB); bf16_t* VTC = (bf16_t*)(ws + WS_VTC);
        for (int t = obid(); t < 256 * 20; t += G) {
            const int rt = t / 20, ct = t % 20, row0 = rt * 64;
            const int csrc = ct < 4 ? C_VB + ct * 64 : C_VC + (ct - 4) * 64;
            bf16_t* dst = ct < 4 ? VTB + (size_t)(ct * 64) * NTOK : VTC + (size_t)((ct - 4) * 64) * NTOK;
            { const int tk = tid >> 3, c8 = (tid & 7) * 8; const u32x4 v = *(const u32x4*)(U + (size_t)(row0 + tk) * ULD + csrc + c8);
              unsigned* d = (unsigned*)(tb + tk * 72 + c8); d[0] = v.x; d[1] = v.y; d[2] = v.z; d[3] = v.w; }
            __syncthreads();
            { const int cc = tid >> 3, t8 = (tid & 7) * 8; const bf16_t* s = tb + t8 * 72 + cc;
              u32x4 w; w.x = (unsigned)s[0] | ((unsigned)s[72] << 16); w.y = (unsigned)s[144] | ((unsigned)s[216] << 16);
              w.z = (unsigned)s[288] | ((unsigned)s[360] << 16); w.w = (unsigned)s[432] | ((unsigned)s[504] << 16);
              *(u32x4*)(dst + (size_t)cc * NTOK + row0 + t8) = w; }
            __syncthreads();
        }
    }
}

#define MFMA32(a, b, c) __builtin_amdgcn_mfma_f32_32x32x16_bf16((a), (b), (c), 0, 0, 0)
__device__ __forceinline__ int crow(int reg, int h) { return (reg & 3) + 8 * (reg >> 2) + 4 * h; }

struct AttnAcc { float m, l; f32x16 O[4]; };

template <int MASK>
__device__ __forceinline__ void attn_tile(const bf16_t* kp, const bf16_t* vp  , size_t vld, const bf16x8 (&qf)[8], AttnAcc& A, int hh,
                                          int tq, int tk0, const LAS float* bt, int qc, int kc0) {
    f32x16 s;
#pragma unroll
    for (int i = 0; i < 16; ++i) s[i] = 0.f;
#pragma unroll
    for (int ks = 0; ks < 8; ++ks) { const bf16x8 a = *(const bf16x8*)(kp + 16 * ks); s = MFMA32(a, qf[ks], s); }
    float mx = NEG;
    int c0 = 0;
    if (MASK == 2) { c0 = qc - 8; c0 = c0 < 0 ? 0 : (c0 > 48 ? 48 : c0); }
#pragma unroll
    for (int i = 0; i < 16; ++i) {
        float v = s[i] * QSCALE;
        if (MASK == 1) { const int dk = tq - (tk0 + crow(i, hh)); v = (dk > 128 || dk < -128) ? NEG : v; }
        if (MASK == 2) { const int kc = kc0 + crow(i, hh); const bool ok = kc >= c0 && kc < c0 + 16; int dc = kc - qc; dc = dc < -15 ? -15 : (dc > 15 ? 15 : dc);
            v = ok ? v + bt[dc + 15] : NEG; }
        s[i] = v; mx = fmaxf(mx, v);
    }
    mx = fmaxf(mx, __shfl_xor(mx, 32));
    const float mn = fmaxf(A.m, mx), alpha = __expf(A.m - mn);
    float rs = 0.f;
#pragma unroll
    for (int i = 0; i < 16; ++i) { const float e = __expf(s[i] - mn); s[i] = e; rs += e; }
    rs += __shfl_xor(rs, 32);
    A.l = A.l * alpha + rs; A.m = mn;
#pragma unroll
    for (int mt = 0; mt < 4; ++mt)
#pragma unroll
        for (int i = 0; i < 16; ++i) A.O[mt][i] *= alpha;
#pragma unroll
    for (int st = 0; st < 2; ++st) {
        u32x4 pw; pw.x = pk2(s[8 * st], s[8 * st + 1]); pw.y = pk2(s[8 * st + 2], s[8 * st + 3]); pw.z = pk2(s[8 * st + 4], s[8 * st + 5]); pw.w = pk2(s[8 * st + 6], s[8 * st + 7]);
        const bf16x8 pb = __builtin_bit_cast(bf16x8, pw);
#pragma unroll
        for (int mt = 0; mt < 4; ++mt) {
            const bf16_t* vr = vp + (size_t)(32 * mt) * vld + 16 * st;
            const u32x2 lo = *(const u32x2*)vr, hi = *(const u32x2*)(vr + 8);
            u32x4 vw; vw.x = lo.x; vw.y = lo.y; vw.z = hi.x; vw.w = hi.y;
            A.O[mt] = MFMA32(__builtin_bit_cast(bf16x8, vw), pb, A.O[mt]);
        }
    }
}
__device__ __forceinline__ void attn_init(AttnAcc& A, float m0, float l0) {
    A.m = m0; A.l = l0;
#pragma unroll
    for (int mt = 0; mt < 4; ++mt)
#pragma unroll
        for (int i = 0; i < 16; ++i) A.O[mt][i] = 0.f;
}
__device__ __forceinline__ void attn_load_q(bf16x8 (&qf)[8], const bf16_t* qp  ) {
#pragma unroll
    for (int ks = 0; ks < 8; ++ks) qf[ks] = *(const bf16x8*)(qp + 16 * ks);
}
__device__ __forceinline__ void attn_store(const AttnAcc& A, bf16_t* yp  ) {
    const float inv = 1.0f / A.l;
#pragma unroll
    for (int mt = 0; mt < 4; ++mt)
#pragma unroll
        for (int gq = 0; gq < 4; ++gq) { u32x2 w; w.x = pk2(A.O[mt][4 * gq] * inv, A.O[mt][4 * gq + 1] * inv); w.y = pk2(A.O[mt][4 * gq + 2] * inv, A.O[mt][4 * gq + 3] * inv);
            *(u32x2*)(yp + 32 * mt + 8 * gq) = w; }
}

__device__ __forceinline__ void phase_attention(const Params& p, int l, const LAS float* rpb  ) {
    const int lane = otid() & 63, r = lane & 31, hh = lane >> 5, gw = obid() * 8 + (otid() >> 6), nw = gridDim.x * 8;
    unsigned char* ws = p.ws;
    const bf16_t* U = (const bf16_t*)(ws + WS_U);
    const bf16_t* VTB = (const bf16_t*)(ws + WS_VTB); const bf16_t* VTC = (const bf16_t*)(ws + WS_VTC);
    bf16_t* YB = (bf16_t*)(ws + WS_Y) + (size_t)1 * NTOK * 1024; bf16_t* YC = (bf16_t*)(ws + WS_Y) + (size_t)2 * NTOK * 1024;
    for (int un = gw; un < 4096; un += nw) {
        const int isC = un >> 11, u2 = un & 2047, b = u2 >> 6, hd = (u2 >> 3) & 7, qt = u2 & 7;
        const int row = b * 256 + qt * 32 + r, kvh = isC ? hd : (hd >> 2);
        bf16x8 qf[8]; attn_load_q(qf, U + (size_t)row * ULD + (isC ? C_QC : C_QB) + hd * 128 + 8 * hh);
        AttnAcc A; if (isC) attn_init(A, NEG, 0.f); else attn_init(A, p.attn_sink[l * 8 + hd], 1.0f);
        const bf16_t* kb = U + (size_t)(b * 256 + r) * ULD + (isC ? C_KC : C_KB) + kvh * 128 + 8 * hh;
        const bf16_t* vb = (isC ? VTC : VTB) + (size_t)(kvh * 128 + r) * NTOK + b * 256 + 4 * hh;
        for (int kt = 0; kt < 8; ++kt) attn_tile<0>(kb + (size_t)kt * 32 * ULD, vb + kt * 32, NTOK, qf, A, hh, 0, 0, nullptr, 0, 0);
        attn_store(A, (isC ? YC : YB) + (size_t)row * 1024 + hd * 128 + 4 * hh);
    }
    for (int un = gw; un < 2048; un += nw) {
        const int b = un >> 8, hd = (un >> 5) & 7, qt = un & 31, kvh = hd >> 2;
        const int t0 = qt * 32, rowb = NCTX + b * 1024, row = rowb + t0 + r;
        bf16x8 qf[8]; attn_load_q(qf, U + (size_t)row * ULD + C_QB + hd * 128 + 8 * hh);
        AttnAcc A; attn_init(A, p.attn_sink[l * 8 + hd], 1.0f);
        const bf16_t* ck = (const bf16_t*)(ws + WS_CKB) + ((size_t)(b * 4 + l) * 256 + r) * 256 + kvh * 128 + 8 * hh;
        const bf16_t* cv = (const bf16_t*)(ws + WS_CVTB) + (((size_t)(b * 4 + l) * 2 + kvh) * 128 + r) * 256 + 4 * hh;
        for (int kt = 0; kt < 8; ++kt) attn_tile<0>(ck + (size_t)kt * 32 * 256, cv + kt * 32, 256, qf, A, hh, 0, 0, nullptr, 0, 0);
        const bf16_t* kb = U + (size_t)(rowb + r) * ULD + C_KB + kvh * 128 + 8 * hh;
        const bf16_t* vb = VTB + (size_t)(kvh * 128 + r) * NTOK + rowb + 4 * hh;
        int k_lo = t0 - 128, k_hi = t0 + 128; k_lo = k_lo < 0 ? 0 : k_lo; k_hi = k_hi > 992 ? 992 : k_hi;
        for (int k0 = k_lo; k0 <= k_hi; k0 += 32) attn_tile<1>(kb + (size_t)k0 * ULD, vb + k0, NTOK, qf, A, hh, t0 + r, k0, nullptr, 0, 0);
        attn_store(A, YB + (size_t)row * 1024 + hd * 128 + 4 * hh);
    }
    for (int un = gw; un < 2048; un += nw) {
        const int b = un >> 8, hd = (un >> 5) & 7, qr = (un >> 1) & 15, half = un & 1;
        const int rowb = NCTX + b * 1024, qc = half * 32 + r, row = rowb + qr * 64 + qc;
        bf16x8 qf[8]; attn_load_q(qf, U + (size_t)row * ULD + C_QC + hd * 128 + 8 * hh);
        AttnAcc A; attn_init(A, NEG, 0.f);
        const bf16_t* ck = (const bf16_t*)(ws + WS_CKC) + ((size_t)(b * 4 + l) * 256 + r) * 1024 + hd * 128 + 8 * hh;
        const bf16_t* cv = (const bf16_t*)(ws + WS_CVTC) + (((size_t)(b * 4 + l) * 8 + hd) * 128 + r) * 256 + 4 * hh;
        for (int kt = 0; kt < 8; ++kt) attn_tile<0>(ck + (size_t)kt * 32 * 1024, cv + kt * 32, 256, qf, A, hh, 0, 0, nullptr, 0, 0);
        int r0 = qr - 4; r0 = r0 < 0 ? 0 : (r0 > 8 ? 8 : r0);
        const bf16_t* kb = U + (size_t)(rowb + r) * ULD + C_KC + hd * 128 + 8 * hh;
        const bf16_t* vb = VTC + (size_t)(hd * 128 + r) * NTOK + rowb + 4 * hh;
        for (int j = 0; j < 8; ++j) { const int kr = r0 + j; const LAS float* bt = rpb + (hd * 15 + (kr - qr + 7)) * 31;
#pragma unroll
            for (int ct = 0; ct < 2; ++ct) { const int k0 = kr * 64 + ct * 32; attn_tile<2>(kb + (size_t)k0 * ULD, vb + k0, NTOK, qf, A, hh, 0, 0, bt, qc, ct * 32); } }
        attn_store(A, YC + (size_t)row * 1024 + hd * 128 + 4 * hh);
    }
}

__device__ __forceinline__ void ssd_unit(const Params& p, int l, int un, unsigned char* lds_g) {
    const int tid = otid(), dir = tid >> 8, t8 = tid & 255, pp = t8 >> 2, nq = t8 & 3;
    unsigned char* ws = p.ws;
    const bool lat = un < 128;
    const int b = lat ? un >> 4 : (un - 128) >> 4, head = un & 15, grp = head >> 3;
    const int L = lat ? 1024 : 256, rowb = lat ? NCTX + b * 1024 : b * 256;
    const float* X = (const float*)(ws + WS_XACT); const float* DT = (const float*)(ws + WS_DT); const float* DEC = (const float*)(ws + WS_DEC);
    float* YS = (float*)(ws + WS_PRE);
    float* base = (float*)lds_g + dir * (4 * 4096 + 128);
    float* xs = base; float* Bs = base + 4096; float* Cs = base + 8192; float* ys = base + 12288; float* dts = base + 16384; float* decs = base + 16384 + 64;
    float h[16];
    if (lat) { const float* s0 = p.state_ssm + ((((size_t)b * 4 + l) * 2 + dir) * 16 + head) * 4096 + pp * 64 + nq * 16;
#pragma unroll
        for (int i = 0; i < 16; i += 4) { const f32x4 v = *(const f32x4*)(s0 + i); h[i] = v[0]; h[i + 1] = v[1]; h[i + 2] = v[2]; h[i + 3] = v[3]; } }
    else {
#pragma unroll
        for (int i = 0; i < 16; ++i) h[i] = 0.f; }
    for (int c = 0; c < L / 64; ++c) {
        const int tok0 = dir == 0 ? c * 64 : L - 64 * (c + 1);
        for (int i = t8; i < 64 * 16; i += 256) { const int tk = i >> 4, c4 = (i & 15) * 4; const float* src = X + (size_t)(rowb + tok0 + tk) * 1280;
            *(f32x4*)(xs + tk * 64 + c4) = *(const f32x4*)(src + head * 64 + c4);
            *(f32x4*)(Bs + tk * 64 + c4) = *(const f32x4*)(src + 1024 + grp * 64 + c4);
            *(f32x4*)(Cs + tk * 64 + c4) = *(const f32x4*)(src + 1152 + grp * 64 + c4); }
        if (t8 < 64) { dts[t8] = DT[(size_t)(rowb + tok0 + t8) * 32 + dir * 16 + head]; decs[t8] = DEC[(size_t)(rowb + tok0 + t8) * 32 + dir * 16 + head]; }
        __syncthreads();
        for (int i = 0; i < 64; ++i) {
            const int tk = dir == 0 ? i : 63 - i;
            const float coef = dts[tk] * xs[tk * 64 + pp], dec = decs[tk];
            const float* bp = Bs + tk * 64 + nq * 16; const float* cp = Cs + tk * 64 + nq * 16;
            float y = 0.f;
#pragma unroll
            for (int q = 0; q < 16; q += 4) { const f32x4 bv = *(const f32x4*)(bp + q), cv = *(const f32x4*)(cp + q);
#pragma unroll
                for (int j = 0; j < 4; ++j) { h[q + j] = h[q + j] * dec + coef * bv[j]; y += cv[j] * h[q + j]; } }
            y += __shfl_xor(y, 1); y += __shfl_xor(y, 2);
            if (nq == 0) ys[tk * 64 + pp] = y;
        }
        __syncthreads();
        for (int i = t8; i < 64 * 16; i += 256) { const int tk = i >> 4, c4 = (i & 15) * 4;
            *(f32x4*)(YS + ((size_t)dir * NTOK + rowb + tok0 + tk) * 1024 + head * 64 + c4) = *(const f32x4*)(ys + tk * 64 + c4); }
        __syncthreads();
    }
    if (!lat) { float* so = p.out + O_ST + ((((size_t)b * 4 + l) * 2 + dir) * 16 + head) * 4096 + pp * 64 + nq * 16;
#pragma unroll
        for (int i = 0; i < 16; i += 4) *(f32x4*)(so + i) = (f32x4){h[i], h[i + 1], h[i + 2], h[i + 3]}; }
    asm volatile("s_waitcnt vmcnt(0)" ::: "memory");
    __syncthreads();
    {
        const int lane = tid & 63, wave = tid >> 6; const float dsk = p.d_skip[l * 16 + head];
        const bf16_t* U = (const bf16_t*)(ws + WS_U); bf16_t* YD = (bf16_t*)(ws + WS_Y) + (size_t)3 * NTOK * 1024; float* SSQ = (float*)(ws + WS_SSQ);
        for (int tk = wave; tk < L; tk += 8) { const size_t row = rowb + tk, o = row * 1024 + head * 64 + lane;
            const float yf = __hip_atomic_load(YS + o, __ATOMIC_RELAXED, __HIP_MEMORY_SCOPE_AGENT), yb = __hip_atomic_load(YS + (size_t)NTOK * 1024 + o, __ATOMIC_RELAXED, __HIP_MEMORY_SCOPE_AGENT);
            const float xv = X[row * 1280 + head * 64 + lane], zv = bf2f(U[row * ULD + C_Z + head * 64 + lane]);
            const float y = (yf + yb + xv * dsk) * silu_f(zv);
            float q = y * y;
#pragma unroll
            for (int o2 = 32; o2 >= 1; o2 >>= 1) q += __shfl_xor(q, o2);
            const unsigned w = pk2(y, 0.f); YD[o] = (bf16_t)(w & 0xffff);
            if (lane == 0) SSQ[row * 16 + head] = q; }
    }
    __syncthreads();
}

#ifndef N_LAUNCH_MODE
#define N_LAUNCH_MODE 1
#endif
#if N_LAUNCH_MODE == 1
constexpr int NPH = 2 + 9 * DEPTH;

__global__ __launch_bounds__(512, 2) void fwd(Params p, int lo, int hi) {
    extern __shared__ __attribute__((aligned(16))) unsigned char lds_raw[];
    LAS unsigned char* lds = (LAS unsigned char*)lds_raw;
    const int G = gridDim.x;
    unsigned char* ws = p.ws;
    volatile LAS unsigned* misc = (volatile LAS unsigned*)(lds + LDS_MISC);
    if (otid() < 4) misc[otid()] = 0u;
    __syncthreads();
    XcdBarrier bar; bar.bar = (unsigned*)(ws + WS_CTL); bar.x = 0; bar.st = misc;
    const bool multi = hi - lo > 1;
    if (multi) bar = xcd_barrier_post((unsigned*)(ws + WS_CTL), misc);
#define IN(k) (lo <= (k) && (k) < hi)
#define SEAM(k) do { if (IN((k) + 1)) xcd_barrier(bar); } while (0)

    if (IN(0)) { phase_pro0(p, lds_raw); SEAM(0); }
    if (IN(1)) { phase_pro1(p); SEAM(1); }

    const float* mod = (const float*)(ws + WS_MOD);
    bf16_t* U = (bf16_t*)(ws + WS_U);
    bf16_t* H = (bf16_t*)(ws + WS_H);
    for (int l = 0; l < DEPTH; ++l) {
        const int pb = 2 + 9 * l;
        if (IN(pb)) {
            pg8::Gemm g{H, (const bf16_t*)(ws + WS_WIN) + (size_t)l * 16384 * 2048, 2048, 2048, 2048};
            pg8::PlainOrder S; S.init(NTOK, 16384, G, obid()); S.lda = 2048; S.ldb = 2048;
            pg8::EpiIn E{U, (float*)(ws + WS_DTRAW), p.out, l};
            pg8::gemm_phase(lds, g, S, E);
            SEAM(pb);
        }
        if (IN(pb + 1)) { phase_premix(p, l, lds_raw); SEAM(pb + 1); }
        if (IN(pb + 2)) {
            if (G >= 256) {
                if (obid() < 128) ssd_unit(p, l, obid(), lds_raw);
                else if (obid() < 256) { for (int q = 0; q < 4; ++q) ssd_unit(p, l, 128 + (obid() - 128) * 4 + q, lds_raw); }
            } else { for (int un = obid(); un < 640; un += G) ssd_unit(p, l, un, lds_raw); }
            {
                LAS float* rpb = (LAS float*)lds;
                for (int i = otid(); i < 8 * 15 * 31; i += 512) rpb[i] = p.na_rpb[(size_t)l * 8 * 15 * 31 + i];
                __syncthreads();
                phase_attention(p, l, rpb);
                __syncthreads();
            }
            {
                pg8::Gemm g{(const bf16_t*)(ws + WS_POOLED), (const bf16_t*)(ws + WS_WPOOL) + (size_t)l * 4 * 256 * 256, 1024, 256, 256};
                pg8::PoolOrder S; S.init(NTOK, 1024, G, obid());
                pg8::EpiBf16<0> E{(bf16_t*)(ws + WS_Y), 1024};
                pg8::gemm_phase(lds, g, S, E);
            }
            SEAM(pb + 2);
        }
        if (IN(pb + 3)) {
            pg8::Gemm g{(const bf16_t*)(ws + WS_Y), (const bf16_t*)(ws + WS_WB) + (size_t)l * 4 * 2048 * 1024, 1024, 1024, 1024};
            pg8::MergeOrder S; S.init(NTOK, 2048, G, obid());
            pg8::EpiMerge E{U, (const float*)(ws + WS_SSQ), (bf16_t*)(ws + WS_MERGED)};
            pg8::gemm_phase(lds, g, S, E);
            SEAM(pb + 3);
        }
        if (IN(pb + 4)) {
            pg8::Gemm g{(const bf16_t*)(ws + WS_MERGED), (const bf16_t*)(ws + WS_WO) + (size_t)l * 2048 * 2048, 2048, 2048, 2048};
            pg8::PlainOrder S; S.init(NTOK, 2048, G, obid()); S.lda = 2048; S.ldb = 2048;
            pg8::EpiRes E{p.out, mod + (size_t)l * 9 * 12288, 2, (float*)(ws + WS_PRE)};
            pg8::gemm_phase(lds, g, S, E);
            SEAM(pb + 4);
        }
        if (IN(pb + 5)) { phase_ln(p, p.ln1_g + l * 2048, p.ln1_b + l * 2048, mod + (size_t)l * 9 * 12288, 3); SEAM(pb + 5); }
        if (IN(pb + 6)) {
            pg8::Gemm g{H, (const bf16_t*)(ws + WS_W1) + (size_t)l * 8192 * 2048, 2048, 2048, 2048};
            pg8::PlainOrder S; S.init(NTOK, 8192, G, obid()); S.lda = 2048; S.ldb = 2048;
            pg8::EpiBf16<1> E{U, 8192};
            pg8::gemm_phase(lds, g, S, E);
            SEAM(pb + 6);
        }
        if (IN(pb + 7)) {
            pg8::Gemm g{U, (const bf16_t*)(ws + WS_W2) + (size_t)l * 2048 * 8192, 8192, 8192, 8192};
            pg8::PlainOrder S; S.init(NTOK, 2048, G, obid()); S.lda = 8192; S.ldb = 8192;
            pg8::EpiRes E{p.out, mod + (size_t)l * 9 * 12288, 5, (float*)(ws + WS_PRE)};
            pg8::gemm_phase(lds, g, S, E);
            SEAM(pb + 7);
        }
        if (IN(pb + 8)) { phase_ln(p, p.ln2_g + l * 2048, p.ln2_b + l * 2048, l + 1 < DEPTH ? mod + (size_t)(l + 1) * 9 * 12288 : nullptr, 0); if (l + 1 < DEPTH) SEAM(pb + 8); }
    }
#undef IN
#undef SEAM
}

#else

#define LDSDECL extern __shared__ __attribute__((aligned(16))) unsigned char lds_raw[]; LAS unsigned char* lds = (LAS unsigned char*)lds_raw; unsigned char* ws = p.ws; (void)lds; (void)ws;
__global__ __launch_bounds__(512, 2) void k_pro0(Params p) { LDSDECL phase_pro0(p, lds_raw); }
__global__ __launch_bounds__(512, 2) void k_pro1(Params p) { phase_pro1(p); }
__global__ __launch_bounds__(512, 2) void k_ln(Params p, int l, int which) {
    const float* mod = (const float*)(p.ws + WS_MOD);
    if (which == 0) phase_ln(p, p.ln1_g + l * 2048, p.ln1_b + l * 2048, mod + (size_t)l * 9 * 12288, 3);
    else phase_ln(p, p.ln2_g + l * 2048, p.ln2_b + l * 2048, l + 1 < DEPTH ? mod + (size_t)(l + 1) * 9 * 12288 : nullptr, 0);
}
__global__ __launch_bounds__(512, 2) void k_premix(Params p, int l) { LDSDECL phase_premix(p, l, lds_raw); }
__global__ __launch_bounds__(512, 2) void k_ssd(Params p, int l) { LDSDECL
    if (gridDim.x >= 256) {
        if (obid() < 128) ssd_unit(p, l, obid(), lds_raw);
        else if (obid() < 256) { for (int q = 0; q < 4; ++q) ssd_unit(p, l, 128 + (obid() - 128) * 4 + q, lds_raw); }
    } else { for (int un = obid(); un < 640; un += gridDim.x) ssd_unit(p, l, un, lds_raw); }
}
__global__ __launch_bounds__(512, 2) void k_attn(Params p, int l) { LDSDECL
    LAS float* rpb = (LAS float*)lds;
    for (int i = otid(); i < 8 * 15 * 31; i += 512) rpb[i] = p.na_rpb[(size_t)l * 8 * 15 * 31 + i];
    __syncthreads();
    phase_attention(p, l, rpb);
}
__global__ __launch_bounds__(512, 2) void k_gemm1(Params p, int l) { LDSDECL
    pg8::Gemm g{(bf16_t*)(ws + WS_H), (const bf16_t*)(ws + WS_WIN) + (size_t)l * 16384 * 2048, 2048, 2048, 2048};
    pg8::PlainOrder S; S.init(NTOK, 16384, gridDim.x, obid()); S.lda = 2048; S.ldb = 2048;
    pg8::EpiIn E{(bf16_t*)(ws + WS_U), (float*)(ws + WS_DTRAW), p.out, l};
    pg8::gemm_phase(lds, g, S, E); }
__global__ __launch_bounds__(512, 2) void k_pool(Params p, int l) { LDSDECL
    pg8::Gemm g{(const bf16_t*)(ws + WS_POOLED), (const bf16_t*)(ws + WS_WPOOL) + (size_t)l * 4 * 256 * 256, 1024, 256, 256};
    pg8::PoolOrder S; S.init(NTOK, 1024, gridDim.x, obid());
    pg8::EpiBf16<0> E{(bf16_t*)(ws + WS_Y), 1024};
    pg8::gemm_phase(lds, g, S, E); }
__global__ __launch_bounds__(512, 2) void k_merge(Params p, int l) { LDSDECL
    pg8::Gemm g{(const bf16_t*)(ws + WS_Y), (const bf16_t*)(ws + WS_WB) + (size_t)l * 4 * 2048 * 1024, 1024, 1024, 1024};
    pg8::MergeOrder S; S.init(NTOK, 2048, gridDim.x, obid());
    pg8::EpiMerge E{(bf16_t*)(ws + WS_U), (const float*)(ws + WS_SSQ), (bf16_t*)(ws + WS_MERGED)};
    pg8::gemm_phase(lds, g, S, E); }
__global__ __launch_bounds__(512, 2) void k_res(Params p, int l, int which) { LDSDECL
    const float* mod = (const float*)(ws + WS_MOD);
    if (which == 0) {
        pg8::Gemm g{(const bf16_t*)(ws + WS_MERGED), (const bf16_t*)(ws + WS_WO) + (size_t)l * 2048 * 2048, 2048, 2048, 2048};
        pg8::PlainOrder S; S.init(NTOK, 2048, gridDim.x, obid()); S.lda = 2048; S.ldb = 2048;
        pg8::EpiRes E{p.out, mod + (size_t)l * 9 * 12288, 2, (float*)(ws + WS_PRE)};
        pg8::gemm_phase(lds, g, S, E);
    } else {
        pg8::Gemm g{(bf16_t*)(ws + WS_U), (const bf16_t*)(ws + WS_W2) + (size_t)l * 2048 * 8192, 8192, 8192, 8192};
        pg8::PlainOrder S; S.init(NTOK, 2048, gridDim.x, obid()); S.lda = 8192; S.ldb = 8192;
        pg8::EpiRes E{p.out, mod + (size_t)l * 9 * 12288, 5, (float*)(ws + WS_PRE)};
        pg8::gemm_phase(lds, g, S, E);
    } }
__global__ __launch_bounds__(512, 2) void k_mlp1(Params p, int l) { LDSDECL
    pg8::Gemm g{(bf16_t*)(ws + WS_H), (const bf16_t*)(ws + WS_W1) + (size_t)l * 8192 * 2048, 2048, 2048, 2048};
    pg8::PlainOrder S; S.init(NTOK, 8192, gridDim.x, obid()); S.lda = 2048; S.ldb = 2048;
    pg8::EpiBf16<1> E{(bf16_t*)(ws + WS_U), 8192};
    pg8::gemm_phase(lds, g, S, E); }
#endif
extern "C" void kernel_launch(void* const* d_in, const int* in_sizes, int n_in, void* d_out, int out_size, void* d_ws, size_t ws_size, hipStream_t stream) {
    static int grid = 0;
    if (grid == 0) {
        if (n_in != 30 || ws_size < WS_END || (size_t)out_size != O_END) { grid = -1; return; }
        int dev = 0, cus = 0;
        if (hipGetDevice(&dev) != hipSuccess || hipDeviceGetAttribute(&cus, hipDeviceAttributeMultiprocessorCount, dev) != hipSuccess) { grid = -1; return; }
#if N_LAUNCH_MODE == 1
        if (hipFuncSetAttribute((const void*)fwd, hipFuncAttributeMaxDynamicSharedMemorySize, LDS_BYTES) != hipSuccess) { grid = -1; return; }
#else
        const void* ks[] = {(const void*)k_pro0, (const void*)k_pro1, (const void*)k_ln, (const void*)k_premix, (const void*)k_ssd, (const void*)k_attn, (const void*)k_gemm1, (const void*)k_pool,
                            (const void*)k_merge, (const void*)k_res, (const void*)k_mlp1};
        for (auto k : ks) if (hipFuncSetAttribute(k, hipFuncAttributeMaxDynamicSharedMemorySize, LDS_BYTES) != hipSuccess) { grid = -1; return; }
#endif
        grid = cus;
    }
    if (grid < 0) return;
    Params p{};
    const float** f = (const float**)&p;
    for (int i = 0; i < 30; ++i) f[i] = (const float*)d_in[i];
    p.out = (float*)d_out; p.ws = (unsigned char*)d_ws;
    (void)hipMemsetAsync((char*)d_ws + WS_CTL, 0, 65536, stream);
    const dim3 g(grid), b(512);
#if N_LAUNCH_MODE == 1
    hipLaunchKernelGGL(fwd, g, b, LDS_BYTES, stream, p, 0, NPH);
#else
    hipLaunchKernelGGL(k_pro0, g, b, LDS_BYTES, stream, p);
    hipLaunchKernelGGL(k_pro1, g, b, LDS_BYTES, stream, p);
    for (int l = 0; l < DEPTH; ++l) {
        hipLaunchKernelGGL(k_gemm1, g, b, LDS_BYTES, stream, p, l);
        hipLaunchKernelGGL(k_premix, g, b, LDS_BYTES, stream, p, l);
        hipLaunchKernelGGL(k_ssd, g, b, LDS_BYTES, stream, p, l);
        hipLaunchKernelGGL(k_attn, g, b, LDS_BYTES, stream, p, l);
        hipLaunchKernelGGL(k_pool, g, b, LDS_BYTES, stream, p, l);
        hipLaunchKernelGGL(k_merge, g, b, LDS_BYTES, stream, p, l);
        hipLaunchKernelGGL(k_res, g, b, LDS_BYTES, stream, p, l, 0);
        hipLaunchKernelGGL(k_ln, g, b, LDS_BYTES, stream, p, l, 0);
        hipLaunchKernelGGL(k_mlp1, g, b, LDS_BYTES, stream, p, l);
        hipLaunchKernelGGL(k_res, g, b, LDS_BYTES, stream, p, l, 1);
        hipLaunchKernelGGL(k_ln, g, b, LDS_BYTES, stream, p, l, 1);
    }
#endif
}
```

```cpp
#include <hip/hip_runtime.h>
#include <stdint.h>

#define LAS __attribute__((address_space(3)))
typedef unsigned short bf16_t;
typedef short bf16x8 __attribute__((ext_vector_type(8)));
typedef short s16x4 __attribute__((ext_vector_type(4)));
typedef float f32x2 __attribute__((ext_vector_type(2)));
typedef float f32x4 __attribute__((ext_vector_type(4)));
typedef float f32x16 __attribute__((ext_vector_type(16)));
typedef unsigned u32x2 __attribute__((ext_vector_type(2)));
typedef unsigned u32x4 __attribute__((ext_vector_type(4)));

constexpr int D = 2048, NTOK = 16384, NCTX = 8192, DEPTH = 4, DFF = 8192;
constexpr int ULD = 16384 + 128;
constexpr int VLD = 16384 + 128;
constexpr int C_POOL = 0, C_QB = 1024, C_KB = 2048, C_VB = 2304, C_QC = 2560, C_KC = 3584, C_VC = 4608, C_Z = 5632, C_XBC = 6656, C_DT = 7936, C_GATE = 8192;
constexpr int DIN = 16160;
constexpr float ALPHA = 1.6817928305074290f;
constexpr float LN_EPS = 1e-5f, RMS_EPS = 1e-6f, NEG = -1e30f;
constexpr float QSCALE = 0.08838834764831845f;

constexpr size_t O_Y = 0, O_CBK = 33554432, O_CBV = 41943040, O_CCK = 50331648, O_CCV = 83886080, O_ST = 117440512, O_END = 134217728;

constexpr size_t WS_CTL = 0;
constexpr size_t WS_MOD = 65536;
constexpr size_t WS_WIN = WS_MOD + 4ull * 9 * 12288 * 4;
constexpr size_t WS_WPOOL = WS_WIN + 4ull * 16384 * 2048 * 2;
constexpr size_t WS_WB = WS_WPOOL + 4ull * 4 * 256 * 256 * 2;
constexpr size_t WS_WO = WS_WB + 4ull * 4 * 2048 * 1024 * 2;
constexpr size_t WS_W1 = WS_WO + 4ull * 2048 * 2048 * 2;
constexpr size_t WS_W2 = WS_W1 + 4ull * 8192 * 2048 * 2;
constexpr size_t WS_CKP = WS_W2 + 4ull * 8192 * 2048 * 2;
constexpr size_t WS_CVP = WS_CKP + 8ull * 4 * 10 * 8 * 4096 * 2;
constexpr size_t WS_ROPE = WS_CVP + 8ull * 4 * 10 * 8 * 4096 * 2;
constexpr size_t WS_H = WS_ROPE + 64ull * 32 * 8;
constexpr size_t WS_U = WS_H + 16384ull * 2048 * 2;
constexpr size_t WS_DTRAW = WS_U + 16384ull * ULD * 2;
constexpr size_t WS_DT = WS_DTRAW + 16384ull * 32 * 4;
constexpr size_t WS_DEC = WS_DT + 16384ull * 32 * 4;
constexpr size_t WS_POOLED = WS_DEC + 16384ull * 32 * 4;
constexpr size_t WS_XACT = WS_POOLED + 16384ull * 1024 * 2;
constexpr size_t WS_KP = WS_XACT + 16384ull * 1280 * 4;
constexpr size_t WS_VP = WS_KP + 10ull * 512 * 4096 * 2;
constexpr size_t WS_BCN = WS_VP + 10ull * 512 * 4096 * 2;
constexpr size_t WS_XT = WS_BCN + 16384ull * 256 * 2;
constexpr size_t WS_BT = WS_XT + 1024ull * VLD * 2;
constexpr size_t WS_Y = WS_BT + 128ull * VLD * 2;
constexpr size_t WS_SSQ = WS_Y + 4ull * 16384 * 1024 * 2;
constexpr size_t WS_MERGED = WS_SSQ + 16384ull * 16 * 4;
constexpr size_t WS_PRE = WS_MERGED + 16384ull * 2048 * 2;
constexpr size_t WS_END = WS_PRE + 16384ull * 2048 * 4;

constexpr int LDS_BYTES = 147456;
constexpr int LDS_MISC = 131072 + 12288;

struct Params {
    const float *x_prompt, *x_sample, *cache_b_k, *cache_b_v, *cache_c_k, *cache_c_v, *state_ssm, *c, *c_ctx;
    const float *w_ada, *b_ada, *w_in, *w_pool, *pool_scale, *attn_sink, *na_rpb, *conv_w, *conv_b, *a_log, *dt_bias, *d_skip, *ssm_norm,
        *w_branch, *w_o, *ln1_g, *ln1_b, *w_mlp1, *w_mlp2, *ln2_g, *ln2_b;
    float* out;
    unsigned char* ws;
};

__device__ __forceinline__ int otid() { int t = threadIdx.x; asm volatile("" : "+v"(t)); return t; }
__device__ __forceinline__ int obid() { int b = blockIdx.x; asm volatile("" : "+s"(b)); return b; }
__device__ __forceinline__ Params load_params() {
    typedef const __attribute__((address_space(4))) unsigned long long* KA;
    KA k = (KA)__builtin_amdgcn_kernarg_segment_ptr();
    asm volatile("" : "+s"(k));
    Params q;
    unsigned long long* qa = (unsigned long long*)&q;
#pragma unroll
    for (int i = 0; i < (int)(sizeof(Params) / 8); ++i) qa[i] = k[i];
    return q;
}
__device__ __forceinline__ unsigned pk2(float lo, float hi) {
    typedef __bf16 bf2 __attribute__((ext_vector_type(2)));
    f32x2 v = {lo, hi};
    return __builtin_bit_cast(unsigned, __builtin_convertvector(v, bf2));
}
__device__ __forceinline__ float bf2f(unsigned short b) { return __uint_as_float(((unsigned)b) << 16); }
__device__ __forceinline__ float bflo(unsigned w) { return __uint_as_float(w << 16); }
__device__ __forceinline__ float bfhi(unsigned w) { return __uint_as_float(w & 0xffff0000u); }
__device__ __forceinline__ float silu_f(float x) { return x / (1.0f + __expf(-x)); }
__device__ __forceinline__ float sigmoid_f(float x) { return 1.0f / (1.0f + __expf(-x)); }
__device__ __forceinline__ int mod_index(int row) { return row < NCTX ? 0 : 1 + ((row - NCTX) >> 10); }

#define XB_TMO      128
#define XB_XCNT(j)  (256  + 64 * (j))
#define XB_XSUB(j)  (1280 + 64 * (j))
#define XB_XGEN(j)  (2304 + 64 * (j))
#define XB_TOP      3328
#define XB_TOPGEN   3392
#define XCD_BAR_WORDS 3456
#define XB_SPIN_CAP (1u << 20)

__device__ __forceinline__ unsigned xb_ld(unsigned* p)              { return __hip_atomic_load(p, __ATOMIC_RELAXED, __HIP_MEMORY_SCOPE_AGENT); }
__device__ __forceinline__ unsigned xb_add(unsigned* p, unsigned v) { return __hip_atomic_fetch_add(p, v, __ATOMIC_RELAXED, __HIP_MEMORY_SCOPE_AGENT); }
__device__ __forceinline__ unsigned xb_xcc_id() { return (unsigned)__builtin_amdgcn_s_getreg((3 << 11) | 20) & 0xFu; }
#define XB_SPIN(cond, bar) do { unsigned _sp = 0; while (cond) { __builtin_amdgcn_s_sleep(1); \
    if ((++_sp & 255u) == 0u) { if (xb_ld(&(bar)[XB_TMO])) break; if (_sp > XB_SPIN_CAP) { atomicAdd(&(bar)[XB_TMO], 1u); break; } } } } while (0)

struct XcdBarrier { unsigned* bar; unsigned x; volatile LAS unsigned* st; };

__device__ __forceinline__ XcdBarrier xcd_barrier_post(unsigned* bar, volatile LAS unsigned* st) {
    XcdBarrier b; b.bar = bar; b.x = xb_xcc_id(); b.st = st;
    if (threadIdx.x == 0) (void)xb_add(&bar[XB_XCNT(b.x)], 1u);
    return b;
}
__device__ __forceinline__ void xcd_barrier_complete(unsigned* bar, unsigned x, unsigned& nloc, unsigned& nx) {
    const unsigned G = gridDim.x * gridDim.y * gridDim.z;
    unsigned sum, cnt, mine, sp = 0u;
    for (;;) {
        sum = 0u; cnt = 0u; mine = 0u;
#pragma unroll
        for (unsigned j = 0; j < 16; ++j) { const unsigned c = xb_ld(&bar[XB_XCNT(j)]); sum += c; cnt += (c > 0u) ? 1u : 0u; mine = (j == x) ? c : mine; }
        if (sum == G) break;
        __builtin_amdgcn_s_sleep(1);
        if ((++sp & 255u) == 0u) { if (xb_ld(&bar[XB_TMO])) break; if (sp > XB_SPIN_CAP) { atomicAdd(&bar[XB_TMO], 1u); break; } }
    }
    nloc = mine > 0u ? mine : 1u; nx = cnt > 0u ? cnt : 1u;
}
__device__ __forceinline__ void xcd_barrier(const XcdBarrier& b) {
    asm volatile("s_waitcnt vmcnt(0)" ::: "memory");
    __syncthreads();
    if (threadIdx.x == 0) {
        unsigned* bar = b.bar;
        __builtin_amdgcn_s_waitcnt(0);
        unsigned nloc = b.st[0], nx = b.st[1];
        if (nloc == 0u) { xcd_barrier_complete(bar, b.x, nloc, nx); b.st[0] = nloc; b.st[1] = nx; }
        const unsigned old = xb_add(&bar[XB_XSUB(b.x)], 1u);
        const unsigned gen = old / nloc;
        if (old + 1u == (gen + 1u) * nloc) {
            __builtin_amdgcn_fence(__ATOMIC_RELEASE, "agent");
            asm volatile("s_waitcnt vmcnt(0)" ::: "memory");
            const unsigned og = xb_add(&bar[XB_TOP], 1u);
            const unsigned tg = og / nx;
            if (og + 1u == (tg + 1u) * nx) xb_add(&bar[XB_TOPGEN], 1u);
            else XB_SPIN(xb_ld(&bar[XB_TOPGEN]) == tg, bar);
            __builtin_amdgcn_fence(__ATOMIC_ACQUIRE, "agent");
            xb_add(&bar[XB_XGEN(b.x)], 1u);
            asm volatile("s_waitcnt vmcnt(0)" ::: "memory");
        } else {
            XB_SPIN(xb_ld(&bar[XB_XGEN(b.x)]) == gen, bar);
            __builtin_amdgcn_fence(__ATOMIC_ACQUIRE, "agent");
            asm volatile("s_waitcnt vmcnt(0)" ::: "memory");
        }
    }
    __syncthreads();
}

namespace pg8 {
constexpr int BM = 256, BK = 64, HALF = 128, HTB = HALF * BK * 2, STAGE_BYTES = 8 * HTB, NXCD = 8, WGM = 8;
__device__ __forceinline__ int lds_byte(int r, int c) { const int st = (r >> 4) * 2 + (c >> 5), rr = r & 15, cc = c & 31, ob = rr * 64 + cc * 2; return st * 1024 + (ob ^ (((ob >> 9) & 1) << 5)); }
__device__ __forceinline__ void stage_rc(int b, int& R, int& C) { const int st = b / 1024, sb = b % 1024, swz = sb ^ (((sb >> 9) & 1) << 5); R = (st >> 1) * 16 + swz / 64; C = (st & 1) * 32 + (swz % 64) / 2; }
__device__ __forceinline__ int perm32(int rho) { const int n = rho >> 4, i = rho & 15; return 8 * (i >> 2) + 4 * n + (i & 3); }

struct Unit { int pm, pn, z; size_t aoff, boff; };
struct Gemm { const bf16_t* A; const bf16_t* Bt; int lda, ldb, K; };

struct TileOrder {
    int nM, nN, nwg, G, c;
    __device__ void init(int M, int N, int G_, int c_) { nM = M / BM; nN = N / BM; nwg = nM * nN; G = G_; c = c_; }
    __device__ bool tile(long L, int& pm, int& pn) const {
        if (L >= nwg) return false;
        int wgid = (int)L; { const int q = nwg / NXCD, r = nwg % NXCD, xcd = wgid % NXCD, off = wgid / NXCD; wgid = (xcd < r ? xcd * (q + 1) : r * (q + 1) + (xcd - r) * q) + off; }
        const int nig = WGM * nN, gid = wgid / nig, fm = gid * WGM, gsz = (nM - fm) < WGM ? (nM - fm) : WGM;
        pm = fm + ((wgid % nig) % gsz); pn = (wgid % nig) / gsz; return true;
    }
};
struct PlainOrder : TileOrder {
    int lda, ldb;
    __device__ bool next(int i, Unit& u) const { if (!tile((long)i * G + c, u.pm, u.pn)) return false; u.z = 0; u.aoff = (size_t)u.pm * BM * lda; u.boff = (size_t)u.pn * BM * ldb; return true; }
};
struct PoolOrder : TileOrder {
    __device__ bool next(int i, Unit& u) const { if (!tile((long)i * G + c, u.pm, u.pn)) return false; u.z = 0; u.aoff = (size_t)u.pm * BM * 1024 + (size_t)u.pn * 256; u.boff = (size_t)u.pn * 256 * 256; return true; }
};
struct MergeOrder : TileOrder {
    __device__ bool next(int i, Unit& u) const { if (!tile((long)(i >> 2) * G + c, u.pm, u.pn)) return false; u.z = i & 3;
        u.aoff = (size_t)u.z * NTOK * 1024 + (size_t)u.pm * BM * 1024; u.boff = (size_t)u.z * 2048 * 1024 + (size_t)u.pn * BM * 1024; return true; }
};

template <class Epi, class Sched>
__device__ __forceinline__ void gemm_phase(LAS unsigned char* lds, const Gemm g, const Sched& S, const Epi& E) {
    const int tid = otid(), wid = __builtin_amdgcn_readfirstlane(tid >> 6), lane = tid & 63, wr = wid >> 2, wc = wid & 3, fr = lane & 15, fq = lane >> 4;
    const int K = g.K, nt = K / BK;
    unsigned voffA[2], voffB[2];
#pragma unroll
    for (int i = 0; i < 2; ++i) { int R, C; stage_rc(tid * 16 + i * 8192, R, C); const int Rb = Epi::PERM ? ((R & ~31) + perm32(R & 31)) : R;
        voffA[i] = (unsigned)(R * g.lda + C) * 2u; voffB[i] = (unsigned)(Rb * g.ldb + C) * 2u; }
    const size_t kstep = (size_t)(BK * 2);
    const size_t hstepA = (size_t)HALF * g.lda * 2, hstepB = (size_t)HALF * g.ldb * 2;
    const unsigned ldsw = (unsigned)wid * 1024u;
    const int aoff = lds_byte(wr * 64 + fr, fq * 8), boff = lds_byte(wc * 32 + fr, fq * 8);
#define PG8_SA(b, h) (((b) * 2 + (h)) * HTB)
#define PG8_SB(b, h) ((4 + (b) * 2 + (h)) * HTB)
#define PG8_STAGE(bufoff, gbase, voff) do { _Pragma("unroll") for (int _i = 0; _i < 2; ++_i) \
        __builtin_amdgcn_global_load_lds((const unsigned*)((const char*)(gbase) + (voff)[_i]), (LAS unsigned*)(lds + (bufoff) + ldsw + _i * 8192), 16, 0, 0); } while (0)
#define PG8_LDA(dst, b, h) do { _Pragma("unroll") for (int m = 0; m < 4; ++m) _Pragma("unroll") for (int k = 0; k < 2; ++k) dst[m][k] = *(const LAS bf16x8*)(lds + PG8_SA(b, h) + aoff + m * 2048 + k * 1024); } while (0)
#define PG8_LDB(dst, b, h) do { _Pragma("unroll") for (int n = 0; n < 2; ++n) _Pragma("unroll") for (int k = 0; k < 2; ++k) dst[n][k] = *(const LAS bf16x8*)(lds + PG8_SB(b, h) + boff + n * 2048 + k * 1024); } while (0)
#define PG8_MMA(ai, bj, At, Bt) do { __builtin_amdgcn_s_setprio(1); _Pragma("unroll") for (int m = 0; m < 4; ++m) _Pragma("unroll") for (int n = 0; n < 2; ++n) _Pragma("unroll") for (int k = 0; k < 2; ++k) \
        acc[ai][bj][m][n] = __builtin_amdgcn_mfma_f32_16x16x32_bf16(Bt[n][k], At[m][k], acc[ai][bj][m][n], 0, 0, 0); __builtin_amdgcn_s_setprio(0); } while (0)
#define PG8_WAIT_V(n) asm volatile("s_waitcnt vmcnt(" #n ")" ::: "memory")
#define PG8_WAIT_L(n) asm volatile("s_waitcnt lgkmcnt(" #n ")" ::: "memory")
#define PG8_BAR __builtin_amdgcn_s_barrier()
#define PG8_SCHED __builtin_amdgcn_sched_barrier(0)
    Unit cur, nxt; int ui = 0;
    if (!S.next(0, cur)) return;
    f32x4 acc[2][2][4][2];
#pragma unroll
    for (int a = 0; a < 2; ++a)
#pragma unroll
        for (int b = 0; b < 2; ++b)
#pragma unroll
            for (int m = 0; m < 4; ++m)
#pragma unroll
                for (int n = 0; n < 2; ++n) acc[a][b][m][n] = (f32x4){0.f, 0.f, 0.f, 0.f};
    bf16x8 At[4][2], B0[2][2], B1[2][2];
    const char* cA = (const char*)g.A + cur.aoff * 2; const char* cB = (const char*)g.Bt + cur.boff * 2;
    PG8_STAGE(PG8_SB(0, 0), cB, voffB); PG8_STAGE(PG8_SA(0, 0), cA, voffA); PG8_STAGE(PG8_SB(0, 1), cB + hstepB, voffB); PG8_STAGE(PG8_SA(0, 1), cA + hstepA, voffA);
    if (wr == 1) PG8_BAR;
    PG8_WAIT_V(4); PG8_BAR;
    PG8_STAGE(PG8_SB(1, 0), cB + kstep, voffB); PG8_STAGE(PG8_SA(1, 0), cA + kstep, voffA); PG8_STAGE(PG8_SB(1, 1), cB + hstepB + kstep, voffB);
    PG8_WAIT_V(6); PG8_BAR;
    for (;;) {
        const bool has_next = S.next(ui + 1, nxt);
        const char* nA = has_next ? (const char*)g.A + nxt.aoff * 2 : cA; const char* nB = has_next ? (const char*)g.Bt + nxt.boff * 2 : cB;
        for (int t = 0; t < nt; t += 2) {
            const bool last = (t == nt - 2);
            const char* a1 = cA + (size_t)(t + 1) * kstep;
            const char* a2 = last ? nA : cA + (size_t)(t + 2) * kstep; const char* b2 = last ? nB : cB + (size_t)(t + 2) * kstep;
            const char* a3 = a2 + kstep; const char* b3 = b2 + kstep;
            PG8_LDB(B0, 0, 0); PG8_SCHED; PG8_LDA(At, 0, 0); PG8_STAGE(PG8_SA(1, 1), a1 + hstepA, voffA);
            PG8_WAIT_L(8); PG8_BAR; PG8_WAIT_L(0); PG8_MMA(0, 0, At, B0); PG8_BAR; PG8_SCHED;
            PG8_LDB(B1, 0, 1); PG8_STAGE(PG8_SB(0, 0), b2, voffB);
            PG8_BAR; PG8_WAIT_L(0); PG8_MMA(0, 1, At, B1); PG8_BAR;
            PG8_LDA(At, 0, 1); PG8_STAGE(PG8_SA(0, 0), a2, voffA);
            PG8_BAR; PG8_WAIT_L(0); PG8_MMA(1, 0, At, B0); PG8_BAR; PG8_SCHED;
            PG8_STAGE(PG8_SB(0, 1), b2 + hstepB, voffB);
            PG8_WAIT_V(6); PG8_BAR; PG8_MMA(1, 1, At, B1); PG8_BAR;
            PG8_LDB(B0, 1, 0); PG8_SCHED; PG8_LDA(At, 1, 0); PG8_STAGE(PG8_SA(0, 1), a2 + hstepA, voffA);
            PG8_WAIT_L(8); PG8_BAR; PG8_WAIT_L(0); PG8_MMA(0, 0, At, B0); PG8_BAR; PG8_SCHED;
            PG8_LDB(B1, 1, 1); PG8_STAGE(PG8_SB(1, 0), b3, voffB);
            PG8_BAR; PG8_WAIT_L(0); PG8_MMA(0, 1, At, B1); PG8_BAR;
            PG8_LDA(At, 1, 1); PG8_STAGE(PG8_SA(1, 0), a3, voffA);
            PG8_BAR; PG8_WAIT_L(0); PG8_MMA(1, 0, At, B0); PG8_BAR; PG8_SCHED;
            PG8_STAGE(PG8_SB(1, 1), b3 + hstepB, voffB);
            PG8_WAIT_V(6); PG8_BAR; PG8_MMA(1, 1, At, B1); PG8_BAR;
        }
        const bool keep = E(acc, cur, wr, wc, fr, fq);
        if (!has_next) break;
        if (!keep) {
#pragma unroll
            for (int a = 0; a < 2; ++a)
#pragma unroll
                for (int b = 0; b < 2; ++b)
#pragma unroll
                    for (int m = 0; m < 4; ++m)
#pragma unroll
                        for (int n = 0; n < 2; ++n) acc[a][b][m][n] = (f32x4){0.f, 0.f, 0.f, 0.f};
        }
        cur = nxt; cA = nA; cB = nB; ++ui;
    }
    PG8_WAIT_V(0);
    if (wr == 0) PG8_BAR;
    PG8_BAR;
#undef PG8_SA
#undef PG8_SB
#undef PG8_STAGE
#undef PG8_LDA
#undef PG8_LDB
#undef PG8_MMA
#undef PG8_WAIT_V
#undef PG8_WAIT_L
#undef PG8_BAR
#undef PG8_SCHED
}

struct EpiIn {
    static constexpr bool PERM = true;
    bf16_t* U; float* dtraw; float* out; int layer;
    __device__ __forceinline__ bool operator()(f32x4 (&acc)[2][2][4][2], const Unit& u, int wr, int wc, int fr, int fq) const {
        const int rl0 = wr * 64 + fr, cl0 = wc * 32 + 8 * fq, pn = u.pn;
        const bool gate = pn >= 32;
        float* cb = nullptr; int cld = 0;
        if (u.pm < 32) {
            if (pn == 8)  { cb = out + O_CBK + (size_t)(u.pm * 4 + layer) * 256 * 256; cld = 256; }
            else if (pn == 9)  { cb = out + O_CBV + (size_t)(u.pm * 4 + layer) * 256 * 256; cld = 256; }
            else if (pn >= 14 && pn < 18) { cb = out + O_CCK + (size_t)(u.pm * 4 + layer) * 256 * 1024 + (pn - 14) * 256; cld = 1024; }
            else if (pn >= 18 && pn < 22) { cb = out + O_CCV + (size_t)(u.pm * 4 + layer) * 256 * 1024 + (pn - 18) * 256; cld = 1024; }
        }
#pragma unroll
        for (int ai = 0; ai < 2; ++ai)
#pragma unroll
            for (int m = 0; m < 4; ++m) {
                const int rl = rl0 + ai * HALF + m * 16;
                bf16_t* rowp = U + (size_t)(u.pm * BM + rl) * ULD + pn * BM + cl0;
#pragma unroll
                for (int bj = 0; bj < 2; ++bj) {
                    f32x4 v0 = acc[ai][bj][m][0], v1 = acc[ai][bj][m][1];
                    if (cb) { float* cp = cb + (size_t)rl * cld + cl0 + bj * HALF; *(f32x4*)cp = v0; *(f32x4*)(cp + 4) = v1; }
                    if (pn == 31 && wc == 0 && bj == 0) { float* dp = dtraw + (size_t)(u.pm * BM + rl) * 32 + 8 * fq; *(f32x4*)dp = v0; *(f32x4*)(dp + 4) = v1; }
                    if (gate) {
#pragma unroll
                        for (int j = 0; j < 4; ++j) { v0[j] = fmaxf(sigmoid_f(v0[j]), 1e-30f); v1[j] = fmaxf(sigmoid_f(v1[j]), 1e-30f); }
                    }
                    u32x4 w; w.x = pk2(v0[0], v0[1]); w.y = pk2(v0[2], v0[3]); w.z = pk2(v1[0], v1[1]); w.w = pk2(v1[2], v1[3]);
                    *(u32x4*)(rowp + bj * HALF) = w;
                }
            }
        return false;
    }
};
template <int ACT> struct EpiBf16 {
    static constexpr bool PERM = true;
    bf16_t* O; int ldc;
    __device__ __forceinline__ bool operator()(f32x4 (&acc)[2][2][4][2], const Unit& u, int wr, int wc, int fr, int fq) const {
        const int row0 = u.pm * BM + wr * 64 + fr, col0 = u.pn * BM + wc * 32 + 8 * fq;
#pragma unroll
        for (int ai = 0; ai < 2; ++ai)
#pragma unroll
            for (int m = 0; m < 4; ++m) {
                bf16_t* rowp = O + (size_t)(row0 + ai * HALF + m * 16) * ldc + col0;
#pragma unroll
                for (int bj = 0; bj < 2; ++bj) {
                    f32x4 v0 = acc[ai][bj][m][0], v1 = acc[ai][bj][m][1];
                    if (ACT == 1) {
#pragma unroll
                        for (int j = 0; j < 4; ++j) { const float a = fmaxf(v0[j], 0.f), b = fmaxf(v1[j], 0.f); v0[j] = a * a; v1[j] = b * b; }
                    }
                    u32x4 w; w.x = pk2(v0[0], v0[1]); w.y = pk2(v0[2], v0[3]); w.z = pk2(v1[0], v1[1]); w.w = pk2(v1[2], v1[3]);
                    *(u32x4*)(rowp + bj * HALF) = w;
                }
            }
        return false;
    }
};
struct EpiMerge {
    static constexpr bool PERM = true;
    const bf16_t* U; const float* ssq; bf16_t* O;
    __device__ __forceinline__ bool operator()(f32x4 (&acc)[2][2][4][2], const Unit& u, int wr, int wc, int fr, int fq) const {
        const int row0 = u.pm * BM + wr * 64 + fr, col0 = u.pn * BM + wc * 32 + 8 * fq, z = u.z;
#pragma unroll
        for (int ai = 0; ai < 2; ++ai)
#pragma unroll
            for (int m = 0; m < 4; ++m) {
                const int row = row0 + ai * HALF + m * 16;
                float rstd = 1.0f;
                if (z >= 2) { const f32x4* sp = (const f32x4*)(ssq + (size_t)row * 16); const f32x4 a = sp[0], b = sp[1], c = sp[2], d = sp[3];
                    const float s = ((a[0] + a[1]) + (a[2] + a[3])) + ((b[0] + b[1]) + (b[2] + b[3])) + ((c[0] + c[1]) + (c[2] + c[3])) + ((d[0] + d[1]) + (d[2] + d[3]));
                    rstd = 1.0f / sqrtf(s * (1.0f / 1024.0f) + RMS_EPS); }
                const bf16_t* gp = U + (size_t)row * ULD + C_GATE + col0;
#pragma unroll
                for (int bj = 0; bj < 2; ++bj) {
                    const u32x4 gz = *(const u32x4*)(gp + z * 2048 + bj * HALF);
                    float f[8];
                    if (z < 3) {
                        const u32x4 gn = *(const u32x4*)(gp + (z + 1) * 2048 + bj * HALF);
                        const float rn = (z == 2) ? rstd : 1.0f;
                        f[0] = bflo(gz.x) / (bflo(gn.x) * rn); f[1] = bfhi(gz.x) / (bfhi(gn.x) * rn); f[2] = bflo(gz.y) / (bflo(gn.y) * rn); f[3] = bfhi(gz.y) / (bfhi(gn.y) * rn);
                        f[4] = bflo(gz.z) / (bflo(gn.z) * rn); f[5] = bfhi(gz.z) / (bfhi(gn.z) * rn); f[6] = bflo(gz.w) / (bflo(gn.w) * rn); f[7] = bfhi(gz.w) / (bfhi(gn.w) * rn);
                    } else {
                        f[0] = bflo(gz.x) * rstd; f[1] = bfhi(gz.x) * rstd; f[2] = bflo(gz.y) * rstd; f[3] = bfhi(gz.y) * rstd;
                        f[4] = bflo(gz.z) * rstd; f[5] = bfhi(gz.z) * rstd; f[6] = bflo(gz.w) * rstd; f[7] = bfhi(gz.w) * rstd;
                    }
                    f32x4 v0 = acc[ai][bj][m][0], v1 = acc[ai][bj][m][1];
#pragma unroll
                    for (int j = 0; j < 4; ++j) { v0[j] *= f[j]; v1[j] *= f[4 + j]; }
                    if (z < 3) { acc[ai][bj][m][0] = v0; acc[ai][bj][m][1] = v1; }
                    else { u32x4 w; w.x = pk2(v0[0], v0[1]); w.y = pk2(v0[2], v0[3]); w.z = pk2(v1[0], v1[1]); w.w = pk2(v1[2], v1[3]);
                        *(u32x4*)(O + (size_t)row * D + col0 + bj * HALF) = w; }
                }
            }
        return z < 3;
    }
};
struct EpiRes {
    static constexpr bool PERM = false;
    const float* xres; const float* modl; int gi; float* pre;
    __device__ __forceinline__ bool operator()(f32x4 (&acc)[2][2][4][2], const Unit& u, int wr, int wc, int fr, int fq) const {
        const int row0 = u.pm * BM + wr * 64 + fr, col0 = u.pn * BM + wc * 32 + 4 * fq;
        const float* gv = modl + (size_t)mod_index(u.pm * BM) * 12288 + gi * 2048 + col0;
        f32x4 gt[2][2];
#pragma unroll
        for (int bj = 0; bj < 2; ++bj)
#pragma unroll
            for (int n = 0; n < 2; ++n) gt[bj][n] = *(const f32x4*)(gv + bj * HALF + n * 16);
#pragma unroll
        for (int ai = 0; ai < 2; ++ai)
#pragma unroll
            for (int m = 0; m < 4; ++m) {
                const size_t off = (size_t)(row0 + ai * HALF + m * 16) * D + col0;
#pragma unroll
                for (int bj = 0; bj < 2; ++bj)
#pragma unroll
                    for (int n = 0; n < 2; ++n) { const f32x4 xv = *(const f32x4*)(xres + off + bj * HALF + n * 16);
                        *(f32x4*)(pre + off + bj * HALF + n * 16) = xv * ALPHA + gt[bj][n] * acc[ai][bj][m][n]; }
                asm volatile("" ::: "memory");
            }
        return false;
    }
};
}

template <int MODE>
__device__ __forceinline__ void convT_tile(const float* src, size_t lds_src, int k0, int n0, const float* scl, bf16_t* dst, size_t ldd, LAS float* tile) {
    const int tid = otid();
#pragma unroll
    for (int it = 0; it < 2; ++it) {
        const int kk = (tid >> 4) + 32 * it, nn = (tid & 15) * 4, n = n0 + nn;
        int sc = n;
        if (MODE == 1) sc = n < 7968 ? n : (n < 8192 ? -1 : n - 224);
        f32x4 v = (f32x4){0.f, 0.f, 0.f, 0.f};
        if (sc >= 0) v = *(const f32x4*)(src + (size_t)(k0 + kk) * lds_src + sc);
        if (scl) v *= scl[k0 + kk];
        LAS float* t = tile + kk * 65 + nn;
        t[0] = v[0]; t[1] = v[1]; t[2] = v[2]; t[3] = v[3];
    }
    __syncthreads();
    {
        const int n = tid >> 3, k8 = (tid & 7) * 8;
        const LAS float* t = tile + k8 * 65 + n;
        u32x4 w; w.x = pk2(t[0], t[65]); w.y = pk2(t[130], t[195]); w.z = pk2(t[260], t[325]); w.w = pk2(t[390], t[455]);
        *(u32x4*)(dst + (size_t)(n0 + n) * ldd + k0 + k8) = w;
    }
    __syncthreads();
}
template <int MODE>
__device__ __forceinline__ void convT_job(const float* src, size_t lds_src, int K, int N, const float* scl, bf16_t* dst, size_t ldd, LAS float* tile) {
    const int tk = K / 64, tn = N / 64;
    for (int t = obid(); t < tk * tn; t += gridDim.x) convT_tile<MODE>(src, lds_src, (t % tk) * 64, (t / tk) * 64, scl, dst, ldd, tile);
}

__device__ __forceinline__ void phase_pro0(const Params& p, unsigned char* lds_g) {
    LAS unsigned char* lds = (LAS unsigned char*)lds_g;
    const int tid = otid(), lane = tid & 63, wave = __builtin_amdgcn_readfirstlane(tid >> 6), G = gridDim.x;
    unsigned char* ws = p.ws;
    if (obid() < 192) {
        LAS float* sl = (LAS float*)lds;
        LAS float* red = (LAS float*)(lds + 73728);
        for (int i = tid; i < 9 * 2048; i += 512) { const int j = i >> 11, k = i & 2047; const float v = j == 0 ? p.c_ctx[k] : p.c[(j - 1) * 2048 + k]; sl[i] = silu_f(v); }
        __syncthreads();
        float* mod = (float*)(ws + WS_MOD);
        for (int un = obid(); un < 192; un += G) {
            const int l = un / 48, col = (un % 48) * 256 + lane * 4;
            f32x4 a[9];
#pragma unroll
            for (int j = 0; j < 9; ++j) a[j] = (f32x4){0.f, 0.f, 0.f, 0.f};
            const float* wp = p.w_ada + ((size_t)l * 2048 + wave * 256) * 12288 + col;
            for (int k = 0; k < 256; k += 4) {
                f32x4 w[4];
#pragma unroll
                for (int q = 0; q < 4; ++q) w[q] = *(const f32x4*)(wp + (size_t)(k + q) * 12288);
#pragma unroll
                for (int q = 0; q < 4; ++q)
#pragma unroll
                    for (int j = 0; j < 9; ++j) a[j] += w[q] * sl[j * 2048 + wave * 256 + k + q];
            }
            if (wave >= 4) {
#pragma unroll
                for (int j = 0; j < 9; ++j) { LAS float* r = red + ((wave - 4) * 9 + j) * 256 + lane * 4; r[0] = a[j][0]; r[1] = a[j][1]; r[2] = a[j][2]; r[3] = a[j][3]; }
            }
            __syncthreads();
            if (wave < 4) {
#pragma unroll
                for (int j = 0; j < 9; ++j) { LAS float* r = red + (wave * 9 + j) * 256 + lane * 4; r[0] += a[j][0]; r[1] += a[j][1]; r[2] += a[j][2]; r[3] += a[j][3]; }
            }
            __syncthreads();
            for (int i = tid; i < 9 * 256; i += 512) { const int j = i >> 8, cc = i & 255;
                const float s = (red[(0 * 9 + j) * 256 + cc] + red[(1 * 9 + j) * 256 + cc]) + (red[(2 * 9 + j) * 256 + cc] + red[(3 * 9 + j) * 256 + cc]);
                const int n = (un % 48) * 256 + cc;
                mod[((size_t)l * 9 + j) * 12288 + n] = s + p.b_ada[(size_t)l * 12288 + n]; }
            __syncthreads();
        }
    }
    __syncthreads();
    LAS float* tile = (LAS float*)lds;
    for (int l = 0; l < DEPTH; ++l) {
        convT_job<1>(p.w_in + (size_t)l * 2048 * DIN, DIN, 2048, 16384, nullptr, (bf16_t*)(ws + WS_WIN) + (size_t)l * 16384 * 2048, 2048, tile);
        for (int gq = 0; gq < 4; ++gq)
            convT_job<0>(p.w_pool + ((size_t)l * 4 + gq) * 256 * 256, 256, 256, 256, nullptr, (bf16_t*)(ws + WS_WPOOL) + ((size_t)l * 4 + gq) * 256 * 256, 256, tile);
        for (int z = 0; z < 4; ++z) {
            const float* scl = z == 0 ? p.pool_scale + l * 1024 : (z == 3 ? p.ssm_norm + l * 1024 : nullptr);
            convT_job<0>(p.w_branch + ((size_t)l * 4 + z) * 1024 * 2048, 2048, 1024, 2048, scl, (bf16_t*)(ws + WS_WB) + ((size_t)l * 4 + z) * 2048 * 1024, 1024, tile);
        }
        convT_job<0>(p.w_o + (size_t)l * 2048 * 2048, 2048, 2048, 2048, nullptr, (bf16_t*)(ws + WS_WO) + (size_t)l * 2048 * 2048, 2048, tile);
        convT_job<0>(p.w_mlp1 + (size_t)l * 2048 * 8192, 8192, 2048, 8192, nullptr, (bf16_t*)(ws + WS_W1) + (size_t)l * 8192 * 2048, 2048, tile);
        convT_job<0>(p.w_mlp2 + (size_t)l * 8192 * 2048, 2048, 8192, 2048, nullptr, (bf16_t*)(ws + WS_W2) + (size_t)l * 2048 * 8192, 8192, tile);
    }
    {
        const int lane = tid & 63, r = lane & 31, hh = lane >> 5, gwv = obid() * 8 + wave, nwv = G * 8;
        bf16_t* vt = (bf16_t*)lds_g + wave * (32 * 136);
        for (int it = gwv; it < 8 * 4 * 10 * 8; it += nwv) {
            const int bl = it / 80, hs = (it / 8) % 10, tl = it % 8;
            const bool isC = hs >= 2; const int hd = isC ? hs - 2 : hs, Hn = isC ? 8 : 2;
            const float* ksrc = (isC ? p.cache_c_k : p.cache_b_k) + ((size_t)bl * 256 + tl * 32 + r) * (Hn * 128) + hd * 128 + 8 * hh;
            const float* vsrc = (isC ? p.cache_c_v : p.cache_b_v) + ((size_t)bl * 256 + tl * 32 + r) * (Hn * 128) + hd * 128 + 8 * hh;
            bf16_t* kd = (bf16_t*)(ws + WS_CKP) + (size_t)it * 4096 + lane * 8; bf16_t* vd = (bf16_t*)(ws + WS_CVP) + (size_t)it * 4096 + lane * 8;
#pragma unroll
            for (int ks = 0; ks < 8; ++ks) { const f32x4 a = *(const f32x4*)(ksrc + 16 * ks), b2 = *(const f32x4*)(ksrc + 16 * ks + 4);
                u32x4 w; w.x = pk2(a[0], a[1]); w.y = pk2(a[2], a[3]); w.z = pk2(b2[0], b2[1]); w.w = pk2(b2[2], b2[3]); *(u32x4*)(kd + ks * 512) = w;
                const f32x4 c = *(const f32x4*)(vsrc + 16 * ks), d2 = *(const f32x4*)(vsrc + 16 * ks + 4);
                unsigned* t = (unsigned*)(vt + r * 136 + 16 * ks + 8 * hh); t[0] = pk2(c[0], c[1]); t[1] = pk2(c[2], c[3]); t[2] = pk2(d2[0], d2[1]); t[3] = pk2(d2[2], d2[3]); }
            asm volatile("s_waitcnt lgkmcnt(0)" ::: "memory");
#pragma unroll
            for (int st = 0; st < 2; ++st)
#pragma unroll
                for (int mt = 0; mt < 4; ++mt) { const bf16_t* s = vt + (16 * st + 4 * hh) * 136 + 32 * mt + r;
                    u32x4 w; w.x = (unsigned)s[0] | ((unsigned)s[136] << 16); w.y = (unsigned)s[2 * 136] | ((unsigned)s[3 * 136] << 16);
                    w.z = (unsigned)s[8 * 136] | ((unsigned)s[9 * 136] << 16); w.w = (unsigned)s[10 * 136] | ((unsigned)s[11 * 136] << 16);
                    *(u32x4*)(vd + (st * 4 + mt) * 512) = w; }
            asm volatile("s_waitcnt lgkmcnt(0)" ::: "memory");
        }
        if (obid() == 0) { float* rt = (float*)(ws + WS_ROPE);
            for (int i = tid; i < 64 * 32; i += 512) { const float freq = powf(10000.0f, -(float)(i & 31) * (1.0f / 32.0f)); float sn, cs; sincosf((float)(i >> 5) * freq, &sn, &cs); rt[2 * i] = cs; rt[2 * i + 1] = sn; } }
    }
}

__device__ __forceinline__ void phase_pro1(const Params& p) {
    const int lane = otid() & 63, gw = obid() * 8 + __builtin_amdgcn_readfirstlane(otid() >> 6), nw = gridDim.x * 8;
    const float* mod = (const float*)(p.ws + WS_MOD);
    bf16_t* H = (bf16_t*)(p.ws + WS_H);
    for (int row = gw; row < NTOK; row += nw) {
        const float* src = row < NCTX ? p.x_prompt + (size_t)row * D : p.x_sample + (size_t)(row - NCTX) * D;
        const float* mv = mod + (size_t)mod_index(row) * 12288;
#pragma unroll
        for (int i = 0; i < 8; ++i) { const int c = i * 256 + lane * 4; const f32x4 v = *(const f32x4*)(src + c);
            *(f32x4*)(p.out + (size_t)row * D + c) = v;
            const f32x4 sh = *(const f32x4*)(mv + c), sc = *(const f32x4*)(mv + 2048 + c); const f32x4 h = v * (sc + 1.0f) + sh;
            u32x2 w; w.x = pk2(h[0], h[1]); w.y = pk2(h[2], h[3]); *(u32x2*)(H + (size_t)row * D + c) = w; }
    }
}

__device__ __forceinline__ void phase_ln(const Params& p, const float* g, const float* b, const float* modn  , int si  ) {
    const int lane = otid() & 63, gw = obid() * 8 + __builtin_amdgcn_readfirstlane(otid() >> 6), nw = gridDim.x * 8;
    const float* pre = (const float*)(p.ws + WS_PRE);
    bf16_t* H = (bf16_t*)(p.ws + WS_H);
    for (int row = gw; row < NTOK; row += nw) {
        f32x4 v[8]; float s = 0.f;
#pragma unroll
        for (int i = 0; i < 8; ++i) { v[i] = *(const f32x4*)(pre + (size_t)row * D + i * 256 + lane * 4); s += (v[i][0] + v[i][1]) + (v[i][2] + v[i][3]); }
#pragma unroll
        for (int o = 32; o >= 1; o >>= 1) s += __shfl_xor(s, o);
        const float mu = s * (1.0f / 2048.0f); float q = 0.f;
#pragma unroll
        for (int i = 0; i < 8; ++i) { const f32x4 d = v[i] - mu; q += (d[0] * d[0] + d[1] * d[1]) + (d[2] * d[2] + d[3] * d[3]); }
#pragma unroll
        for (int o = 32; o >= 1; o >>= 1) q += __shfl_xor(q, o);
        const float rstd = 1.0f / sqrtf(q * (1.0f / 2048.0f) + LN_EPS);
        const float* mv = modn ? modn + (size_t)mod_index(row) * 12288 + si * 2048 : nullptr;
#pragma unroll
        for (int i = 0; i < 8; ++i) { const int c = i * 256 + lane * 4;
            const f32x4 x = (v[i] - mu) * rstd * *(const f32x4*)(g + c) + *(const f32x4*)(b + c);
            *(f32x4*)(p.out + (size_t)row * D + c) = x;
            if (mv) { const f32x4 sh = *(const f32x4*)(mv + c), sc = *(const f32x4*)(mv + 2048 + c); const f32x4 h = x * (sc + 1.0f) + sh;
                u32x2 w; w.x = pk2(h[0], h[1]); w.y = pk2(h[2], h[3]); *(u32x2*)(H + (size_t)row * D + c) = w; }
        }
    }
}

__device__ __forceinline__ void phase_premix(const Params& p, int l, unsigned char* lds_g, bool do_rope = true) {
    const int tid = otid(), G = gridDim.x;
    const size_t gt = (size_t)obid() * 512 + tid, gs = (size_t)G * 512;
    unsigned char* ws = p.ws;
    bf16_t* U = (bf16_t*)(ws + WS_U);
    {
        bf16_t* P = (bf16_t*)(ws + WS_POOLED);
        for (size_t it = gt; it < (size_t)NTOK * 128; it += gs) {
            const int row = (int)(it >> 7), c8 = (int)(it & 127) * 8, gq = c8 >> 8, w = 2 << gq;
            const int L = row < NCTX ? 256 : 1024, s = row < NCTX ? (row & 255) : ((row - NCTX) & 1023);
            int lo = s - (w >> 1), hi = s + (w >> 1); lo = lo < 0 ? 0 : lo; hi = hi > L ? L : hi;
            float a[8];
#pragma unroll
            for (int j = 0; j < 8; ++j) a[j] = 0.f;
            const bf16_t* base = U + (size_t)(row - s) * ULD + C_POOL + c8;
            for (int j = lo; j < hi; ++j) { const u32x4 v = *(const u32x4*)(base + (size_t)j * ULD);
                a[0] += bflo(v.x); a[1] += bfhi(v.x); a[2] += bflo(v.y); a[3] += bfhi(v.y); a[4] += bflo(v.z); a[5] += bfhi(v.z); a[6] += bflo(v.w); a[7] += bfhi(v.w); }
            const float inv = 1.0f / (float)(hi - lo);
            const u32x4 v = *(const u32x4*)(base + (size_t)s * ULD);
            u32x4 o; o.x = pk2(a[0] * inv - bflo(v.x), a[1] * inv - bfhi(v.x)); o.y = pk2(a[2] * inv - bflo(v.y), a[3] * inv - bfhi(v.y));
            o.z = pk2(a[4] * inv - bflo(v.z), a[5] * inv - bfhi(v.z)); o.w = pk2(a[6] * inv - bflo(v.w), a[7] * inv - bfhi(v.w));
            *(u32x4*)(P + (size_t)row * 1024 + c8) = o;
        }
    }
    {
        float* X = (float*)(ws + WS_XACT); bf16_t* BCN = (bf16_t*)(ws + WS_BCN); bf16_t* XT = (bf16_t*)(ws + WS_XT); bf16_t* BT = (bf16_t*)(ws + WS_BT);
        bf16_t* tb = (bf16_t*)lds_g;
        const float* cw = p.conv_w + (size_t)l * 5 * 1280; const float* cbias = p.conv_b + (size_t)l * 1280;
        for (int t = obid(); t < 256 * 20; t += G) {
            const int rt = t / 20, ct = t % 20, row0 = rt * 64, ch0 = ct * 64;
            const int tk = tid >> 3, c8 = ch0 + (tid & 7) * 8, row = row0 + tk;
            const int L = row < NCTX ? 256 : 1024, s = row < NCTX ? (row & 255) : ((row - NCTX) & 1023);
            float a[8];
#pragma unroll
            for (int j = 0; j < 8; ++j) a[j] = cbias[c8 + j];
#pragma unroll
            for (int k = 0; k < 5; ++k) { const int sj = s + k - 2; if (sj < 0 || sj >= L) continue;
                const u32x4 v = *(const u32x4*)(U + (size_t)(row + k - 2) * ULD + C_XBC + c8);
                const f32x4 w0 = *(const f32x4*)(cw + k * 1280 + c8), w1 = *(const f32x4*)(cw + k * 1280 + c8 + 4);
                a[0] += bflo(v.x) * w0[0]; a[1] += bfhi(v.x) * w0[1]; a[2] += bflo(v.y) * w0[2]; a[3] += bfhi(v.y) * w0[3];
                a[4] += bflo(v.z) * w1[0]; a[5] += bfhi(v.z) * w1[1]; a[6] += bflo(v.w) * w1[2]; a[7] += bfhi(v.w) * w1[3]; }
#pragma unroll
            for (int j = 0; j < 8; ++j) a[j] = silu_f(a[j]);
            u32x4 w; w.x = pk2(a[0], a[1]); w.y = pk2(a[2], a[3]); w.z = pk2(a[4], a[5]); w.w = pk2(a[6], a[7]);
            if (ct < 16) { *(f32x4*)(X + (size_t)row * 1280 + c8) = (f32x4){a[0], a[1], a[2], a[3]}; *(f32x4*)(X + (size_t)row * 1280 + c8 + 4) = (f32x4){a[4], a[5], a[6], a[7]}; }
            else *(u32x4*)(BCN + (size_t)row * 256 + (c8 - 1024)) = w;
            if (ct < 18) {
                { unsigned* d = (unsigned*)(tb + tk * 72 + (tid & 7) * 8); d[0] = w.x; d[1] = w.y; d[2] = w.z; d[3] = w.w; }
                __syncthreads();
                { const int cc = tid >> 3, t8 = (tid & 7) * 8; const bf16_t* sp = tb + t8 * 72 + cc;
                  u32x4 o; o.x = (unsigned)sp[0] | ((unsigned)sp[72] << 16); o.y = (unsigned)sp[144] | ((unsigned)sp[216] << 16);
                  o.z = (unsigned)sp[288] | ((unsigned)sp[360] << 16); o.w = (unsigned)sp[432] | ((unsigned)sp[504] << 16);
                  bf16_t* dst = ct < 16 ? XT + (size_t)(ch0 + cc) * VLD : BT + (size_t)(ch0 - 1024 + cc) * VLD;
                  *(u32x4*)(dst + row0 + t8) = o; }
                __syncthreads();
            }
        }
    }
    {
        const float* raw = (const float*)(ws + WS_DTRAW); float* DT = (float*)(ws + WS_DT); float* DEC = (float*)(ws + WS_DEC);
        for (size_t it = gt; it < (size_t)NTOK * 32; it += gs) { const int j = (int)(it & 31);
            const float x = raw[it] + p.dt_bias[l * 32 + j]; const float dt = x > 20.f ? x : log1pf(expf(x));
            const float a = -expf(p.a_log[l * 32 + j]);
            DT[it] = dt; DEC[it] = dt * a; }
    }
    if (do_rope) {
        const float* rt = (const float*)(ws + WS_ROPE);
        for (size_t it = gt; it < (size_t)8192 * 8 * 64; it += gs) {
            const int t = (int)(it >> 9), rem = (int)(it & 511), hd = rem >> 6, pi = rem & 63, half = pi >> 5, i = pi & 31;
            const int tt = t & 1023, pos = half == 0 ? (tt >> 6) : (tt & 63);
            const f32x2 cssn = *(const f32x2*)(rt + (pos * 32 + i) * 2);
            bf16_t* q = U + (size_t)(NCTX + t) * ULD + C_QB + hd * 128 + half * 64 + i;
            const float x1 = bf2f(q[0]), x2 = bf2f(q[32]);
            const unsigned w = pk2(x1 * cssn[0] - x2 * cssn[1], x1 * cssn[1] + x2 * cssn[0]);
            q[0] = (bf16_t)(w & 0xffff); q[32] = (bf16_t)(w >> 16);
        }
    }
    {
        const int lane = tid & 63, wave = __builtin_amdgcn_readfirstlane(tid >> 6), r = lane & 31, hh = lane >> 5, gwv = obid() * 8 + wave, nwv = G * 8;
        bf16_t* vt = (bf16_t*)lds_g + wave * (32 * 136);
        const float* rt = (const float*)(ws + WS_ROPE);
        for (int it = gwv; it < 10 * 512; it += nwv) {
            const int hs = it >> 9, T = it & 511, row = T * 32 + r;
            const bool isC = hs >= 2; const int hd = isC ? hs - 2 : hs;
            const bf16_t* ksrc = U + (size_t)row * ULD + (isC ? C_KC : C_KB) + hd * 128 + 8 * hh;
            const bf16_t* vsrc = U + (size_t)row * ULD + (isC ? C_VC : C_VB) + hd * 128 + 8 * hh;
            bf16_t* kd = (bf16_t*)(ws + WS_KP) + (size_t)it * 4096 + lane * 8; bf16_t* vd = (bf16_t*)(ws + WS_VP) + (size_t)it * 4096 + lane * 8;
            u32x4 kf[8];
#pragma unroll
            for (int ks = 0; ks < 8; ++ks) { kf[ks] = *(const u32x4*)(ksrc + 16 * ks);
                const u32x4 v = *(const u32x4*)(vsrc + 16 * ks); unsigned* t = (unsigned*)(vt + r * 136 + 16 * ks + 8 * hh); t[0] = v.x; t[1] = v.y; t[2] = v.z; t[3] = v.w; }
            if (!isC && row >= NCTX) {
                const int tt = (row - NCTX) & 1023;
#pragma unroll
                for (int half = 0; half < 2; ++half) { const int pos = half == 0 ? (tt >> 6) : (tt & 63);
#pragma unroll
                    for (int k2 = 0; k2 < 2; ++k2) { const int ks = half * 4 + k2; const float* tp = rt + (pos * 32 + 16 * k2 + 8 * hh) * 2;
                        unsigned a[4] = {kf[ks].x, kf[ks].y, kf[ks].z, kf[ks].w}, b2[4] = {kf[ks + 2].x, kf[ks + 2].y, kf[ks + 2].z, kf[ks + 2].w};
#pragma unroll
                        for (int q = 0; q < 4; ++q) { const f32x4 cs = *(const f32x4*)(tp + 4 * q);
                            const float x1l = bflo(a[q]), x1h = bfhi(a[q]), x2l = bflo(b2[q]), x2h = bfhi(b2[q]);
                            a[q] = pk2(x1l * cs[0] - x2l * cs[1], x1h * cs[2] - x2h * cs[3]); b2[q] = pk2(x1l * cs[1] + x2l * cs[0], x1h * cs[3] + x2h * cs[2]); }
                        kf[ks].x = a[0]; kf[ks].y = a[1]; kf[ks].z = a[2]; kf[ks].w = a[3]; kf[ks + 2].x = b2[0]; kf[ks + 2].y = b2[1]; kf[ks + 2].z = b2[2]; kf[ks + 2].w = b2[3]; } }
            }
#pragma unroll
            for (int ks = 0; ks < 8; ++ks) *(u32x4*)(kd + ks * 512) = kf[ks];
            asm volatile("s_waitcnt lgkmcnt(0)" ::: "memory");
#pragma unroll
            for (int st = 0; st < 2; ++st)
#pragma unroll
                for (int mt = 0; mt < 4; ++mt) { const bf16_t* s = vt + (16 * st + 4 * hh) * 136 + 32 * mt + r;
                    u32x4 w; w.x = (unsigned)s[0] | ((unsigned)s[136] << 16); w.y = (unsigned)s[2 * 136] | ((unsigned)s[3 * 136] << 16);
                    w.z = (unsigned)s[8 * 136] | ((unsigned)s[9 * 136] << 16); w.w = (unsigned)s[10 * 136] | ((unsigned)s[11 * 136] << 16);
                    *(u32x4*)(vd + (st * 4 + mt) * 512) = w; }
            asm volatile("s_waitcnt lgkmcnt(0)" ::: "memory");
        }
    }
}

#define MFMA32(a, b, c) __builtin_amdgcn_mfma_f32_32x32x16_bf16((a), (b), (c), 0, 0, 0)
__device__ __forceinline__ int crow(int reg, int h) { return (reg & 3) + 8 * (reg >> 2) + 4 * h; }

struct AttnAcc { float m, l; f32x16 O[4]; };

template <int MASK>
__device__ __forceinline__ void attn_tile(bf16x8 (&kf)[8], const bf16_t* kn_p  , const bf16_t* vp  , const bf16x8 (&qf)[8], AttnAcc& A, int hh,
                                          int tq, int tk0, const LAS float* bt, int qc, int kc0) {
    bf16x8 vf[8], kn[8];
#pragma unroll
    for (int i = 0; i < 4; ++i) vf[i] = *(const bf16x8*)(vp + 512 * i);
#pragma unroll
    for (int i = 0; i < 8; ++i) kn[i] = *(const bf16x8*)(kn_p + 512 * i);
    __builtin_amdgcn_sched_barrier(0);
    f32x16 s;
#pragma unroll
    for (int i = 0; i < 16; ++i) s[i] = 0.f;
#pragma unroll
    for (int ks = 0; ks < 8; ++ks) s = MFMA32(kf[ks], qf[ks], s);
    __builtin_amdgcn_sched_barrier(0);
#pragma unroll
    for (int i = 4; i < 8; ++i) vf[i] = *(const bf16x8*)(vp + 512 * i);
    __builtin_amdgcn_sched_barrier(0);
    float mx = NEG;
    int c0 = 0;
    if (MASK == 2) { c0 = qc - 8; c0 = c0 < 0 ? 0 : (c0 > 48 ? 48 : c0); }
#pragma unroll
    for (int i = 0; i < 16; ++i) {
        float v = s[i] * QSCALE;
        if (MASK == 1) { const int dk = tq - (tk0 + crow(i, hh)); v = (dk > 128 || dk < -128) ? NEG : v; }
        if (MASK == 2) { const int kc = kc0 + crow(i, hh); const bool ok = kc >= c0 && kc < c0 + 16; int dc = kc - qc; dc = dc < -15 ? -15 : (dc > 15 ? 15 : dc);
            v = ok ? v + bt[dc + 15] : NEG; }
        s[i] = v; mx = fmaxf(mx, v);
    }
    mx = fmaxf(mx, __shfl_xor(mx, 32));
    const float mn = fmaxf(A.m, mx), alpha = __expf(A.m - mn);
    float rs = 0.f;
#pragma unroll
    for (int i = 0; i < 16; ++i) { const float e = __expf(s[i] - mn); s[i] = e; rs += e; }
    rs += __shfl_xor(rs, 32);
    A.l = A.l * alpha + rs; A.m = mn;
#pragma unroll
    for (int mt = 0; mt < 4; ++mt)
#pragma unroll
        for (int i = 0; i < 16; ++i) A.O[mt][i] *= alpha;
#pragma unroll
    for (int st = 0; st < 2; ++st) {
        u32x4 pw; pw.x = pk2(s[8 * st], s[8 * st + 1]); pw.y = pk2(s[8 * st + 2], s[8 * st + 3]); pw.z = pk2(s[8 * st + 4], s[8 * st + 5]); pw.w = pk2(s[8 * st + 6], s[8 * st + 7]);
        const bf16x8 pb = __builtin_bit_cast(bf16x8, pw);
#pragma unroll
        for (int mt = 0; mt < 4; ++mt) A.O[mt] = MFMA32(vf[st * 4 + mt], pb, A.O[mt]);
    }
    __builtin_amdgcn_sched_barrier(0);
#pragma unroll
    for (int i = 0; i < 8; ++i) kf[i] = kn[i];
}
__device__ __forceinline__ void attn_load_k(bf16x8 (&kf)[8], const bf16_t* kp) {
#pragma unroll
    for (int i = 0; i < 8; ++i) kf[i] = *(const bf16x8*)(kp + 512 * i);
}
__device__ __forceinline__ void attn_init(AttnAcc& A, float m0, float l0) {
    A.m = m0; A.l = l0;
#pragma unroll
    for (int mt = 0; mt < 4; ++mt)
#pragma unroll
        for (int i = 0; i < 16; ++i) A.O[mt][i] = 0.f;
}
__device__ __forceinline__ void attn_load_q(bf16x8 (&qf)[8], const bf16_t* qp  ) {
#pragma unroll
    for (int ks = 0; ks < 8; ++ks) qf[ks] = *(const bf16x8*)(qp + 16 * ks);
}
__device__ __forceinline__ void attn_store(const AttnAcc& A, bf16_t* yp  ) {
    const float inv = 1.0f / A.l;
#pragma unroll
    for (int mt = 0; mt < 4; ++mt)
#pragma unroll
        for (int gq = 0; gq < 4; ++gq) { u32x2 w; w.x = pk2(A.O[mt][4 * gq] * inv, A.O[mt][4 * gq + 1] * inv); w.y = pk2(A.O[mt][4 * gq + 2] * inv, A.O[mt][4 * gq + 3] * inv);
            *(u32x2*)(yp + 32 * mt + 8 * gq) = w; }
}

__device__ __forceinline__ void phase_attention(const Params& p, int l, const LAS float* rpb  ) {
    const int lane = otid() & 63, r = lane & 31, hh = lane >> 5, gw = obid() * 8 + __builtin_amdgcn_readfirstlane(otid() >> 6), nw = gridDim.x * 8;
    unsigned char* ws = p.ws;
    const bf16_t* U = (const bf16_t*)(ws + WS_U);
    const bf16_t* KP = (const bf16_t*)(ws + WS_KP) + lane * 8; const bf16_t* VP = (const bf16_t*)(ws + WS_VP) + lane * 8;
    const bf16_t* CKP = (const bf16_t*)(ws + WS_CKP) + lane * 8; const bf16_t* CVP = (const bf16_t*)(ws + WS_CVP) + lane * 8;
    bf16_t* YB = (bf16_t*)(ws + WS_Y) + (size_t)1 * NTOK * 1024; bf16_t* YC = (bf16_t*)(ws + WS_Y) + (size_t)2 * NTOK * 1024;
    for (int un = gw; un < 4096; un += nw) {
        const int isC = un >> 11, u2 = un & 2047, b = u2 >> 6, hd = (u2 >> 3) & 7, qt = u2 & 7;
        const int row = b * 256 + qt * 32 + r, hs = isC ? 2 + hd : (hd >> 2);
        const size_t tb = ((size_t)hs * 512 + b * 8) * 4096;
        bf16x8 kf[8]; attn_load_k(kf, KP + tb);
        bf16x8 qf[8]; attn_load_q(qf, U + (size_t)row * ULD + (isC ? C_QC : C_QB) + hd * 128 + 8 * hh);
        AttnAcc A; if (isC) attn_init(A, NEG, 0.f); else attn_init(A, p.attn_sink[l * 8 + hd], 1.0f);
        for (int kt = 0; kt < 8; ++kt) attn_tile<0>(kf, KP + tb + (size_t)(kt < 7 ? kt + 1 : 7) * 4096, VP + tb + (size_t)kt * 4096, qf, A, hh, 0, 0, nullptr, 0, 0);
        attn_store(A, (isC ? YC : YB) + (size_t)row * 1024 + hd * 128 + 4 * hh);
    }
    for (int un = gw; un < 2048; un += nw) {
        const int b = un >> 8, hd = (un >> 5) & 7, qt = un & 31, kvh = hd >> 2;
        const int t0 = qt * 32, rowb = NCTX + b * 1024, row = rowb + t0 + r;
        const size_t cb = (((size_t)(b * 4 + l) * 10 + kvh) * 8) * 4096;
        const size_t tb = ((size_t)kvh * 512 + rowb / 32) * 4096;
        int k_lo = t0 - 128, k_hi = t0 + 128; k_lo = k_lo < 0 ? 0 : k_lo; k_hi = k_hi > 992 ? 992 : k_hi;
        bf16x8 kf[8]; attn_load_k(kf, CKP + cb);
        bf16x8 qf[8]; attn_load_q(qf, U + (size_t)row * ULD + C_QB + hd * 128 + 8 * hh);
        AttnAcc A; attn_init(A, p.attn_sink[l * 8 + hd], 1.0f);
        for (int kt = 0; kt < 8; ++kt) attn_tile<0>(kf, kt < 7 ? CKP + cb + (size_t)(kt + 1) * 4096 : KP + tb + (size_t)(k_lo >> 5) * 4096, CVP + cb + (size_t)kt * 4096, qf, A, hh, 0, 0, nullptr, 0, 0);
        for (int k0 = k_lo; k0 <= k_hi; k0 += 32) { const int kn0 = k0 + 32 <= k_hi ? k0 + 32 : k0;
            attn_tile<1>(kf, KP + tb + (size_t)(kn0 >> 5) * 4096, VP + tb + (size_t)(k0 >> 5) * 4096, qf, A, hh, t0 + r, k0, nullptr, 0, 0); }
        attn_store(A, YB + (size_t)row * 1024 + hd * 128 + 4 * hh);
    }
    for (int un = gw; un < 2048; un += nw) {
        const int b = un >> 8, hd = (un >> 5) & 7, qr = (un >> 1) & 15, half = un & 1;
        const int rowb = NCTX + b * 1024, qc = half * 32 + r, row = rowb + qr * 64 + qc;
        int r0 = qr - 4; r0 = r0 < 0 ? 0 : (r0 > 8 ? 8 : r0);
        const size_t cb = (((size_t)(b * 4 + l) * 10 + 2 + hd) * 8) * 4096;
        const size_t tb = ((size_t)(2 + hd) * 512 + rowb / 32 + r0 * 2) * 4096;
        bf16x8 kf[8]; attn_load_k(kf, CKP + cb);
        bf16x8 qf[8]; attn_load_q(qf, U + (size_t)row * ULD + C_QC + hd * 128 + 8 * hh);
        AttnAcc A; attn_init(A, NEG, 0.f);
        for (int kt = 0; kt < 8; ++kt) attn_tile<0>(kf, kt < 7 ? CKP + cb + (size_t)(kt + 1) * 4096 : KP + tb, CVP + cb + (size_t)kt * 4096, qf, A, hh, 0, 0, nullptr, 0, 0);
        for (int lt = 0; lt < 16; ++lt) { const int kr = r0 + (lt >> 1); const LAS float* bt = rpb + (hd * 15 + (kr - qr + 7)) * 31;
            attn_tile<2>(kf, KP + tb + (size_t)(lt < 15 ? lt + 1 : 15) * 4096, VP + tb + (size_t)lt * 4096, qf, A, hh, 0, 0, bt, qc, (lt & 1) * 32); }
        attn_store(A, YC + (size_t)row * 1024 + hd * 128 + 4 * hh);
    }
}

__device__ __forceinline__ bf16x8 pack8(const f32x16& x, int s8) {
    u32x4 w; w.x = pk2(x[s8], x[s8 + 1]); w.y = pk2(x[s8 + 2], x[s8 + 3]); w.z = pk2(x[s8 + 4], x[s8 + 5]); w.w = pk2(x[s8 + 6], x[s8 + 7]);
    return __builtin_bit_cast(bf16x8, w);
}
__device__ __forceinline__ bf16x8 ld2x8(const bf16_t* p) {
    const u32x2 lo = *(const u32x2*)p, hi = *(const u32x2*)(p + 8); u32x4 w; w.x = lo.x; w.y = lo.y; w.z = hi.x; w.w = hi.y; return __builtin_bit_cast(bf16x8, w);
}
__device__ __forceinline__ void ssd_seq(const Params& p, int l, bool lat, int b, int head, int dir, int ph, LAS float* wl, int lane) {
    const int r = lane & 31, hh = lane >> 5, grp = head >> 3;
    unsigned char* ws = p.ws;
    const int L = lat ? 1024 : 256, rowb = lat ? NCTX + b * 1024 : b * 256;
    const float* DT = (const float*)(ws + WS_DT); const float* DA = (const float*)(ws + WS_DEC);
    const bf16_t* BCN = (const bf16_t*)(ws + WS_BCN); const bf16_t* XT = (const bf16_t*)(ws + WS_XT) + (size_t)(head * 64 + 32 * ph + r) * VLD + 4 * hh;
    const bf16_t* BT = (const bf16_t*)(ws + WS_BT) + (size_t)(grp * 64 + r) * VLD + 4 * hh;
    float* YS = (float*)(ws + WS_PRE) + (size_t)dir * NTOK * 1024 + head * 64 + 32 * ph + r;
    f32x16 hT[2];
    if (lat) { const float* s0 = p.state_ssm + (((((size_t)b * 4 + l) * 2 + dir) * 16 + head) * 64 + 32 * ph + r) * 64 + 4 * hh;
#pragma unroll
        for (int nt = 0; nt < 2; ++nt)
#pragma unroll
            for (int g = 0; g < 4; ++g) { const f32x4 v = *(const f32x4*)(s0 + 32 * nt + 8 * g); hT[nt][4 * g] = v[0]; hT[nt][4 * g + 1] = v[1]; hT[nt][4 * g + 2] = v[2]; hT[nt][4 * g + 3] = v[3]; } }
    else {
#pragma unroll
        for (int nt = 0; nt < 2; ++nt)
#pragma unroll
            for (int i = 0; i < 16; ++i) hT[nt][i] = 0.f; }
    for (int c = 0; c < L / 64; ++c) {
        const int row0 = rowb + (dir == 0 ? c * 64 : L - 64 * (c + 1));
        const float dtv = DT[(size_t)(row0 + lane) * 32 + dir * 16 + head]; float cum = DA[(size_t)(row0 + lane) * 32 + dir * 16 + head];
        if (dir == 0) {
#pragma unroll
            for (int o = 1; o < 64; o <<= 1) { const float t = __shfl_up(cum, o); if (lane >= o) cum += t; }
        } else {
#pragma unroll
            for (int o = 1; o < 64; o <<= 1) { const float t = __shfl_down(cum, o); if (lane + o < 64) cum += t; }
        }
        const float tot = __shfl(cum, dir == 0 ? 63 : 0);
        asm volatile("s_waitcnt lgkmcnt(0)" ::: "memory");
        wl[lane] = cum; wl[64 + lane] = dtv; wl[128 + lane] = __expf(cum); wl[192 + lane] = __expf(tot - cum) * dtv;
        asm volatile("s_waitcnt lgkmcnt(0)" ::: "memory");
        const float cdec = __expf(tot);
        bf16x8 xf[2][2];
#pragma unroll
        for (int jt = 0; jt < 2; ++jt)
#pragma unroll
            for (int st = 0; st < 2; ++st) xf[jt][st] = ld2x8(XT + row0 + 32 * jt + 16 * st);
        f32x16 Y[2];
        bf16x8 hb[2][2];
#pragma unroll
        for (int nt = 0; nt < 2; ++nt)
#pragma unroll
            for (int st = 0; st < 2; ++st) hb[nt][st] = pack8(hT[nt], 8 * st);
#pragma unroll
        for (int it = 0; it < 2; ++it) {
#pragma unroll
            for (int i = 0; i < 16; ++i) Y[it][i] = 0.f;
            const bf16_t* cp = BCN + (size_t)(row0 + 32 * it + r) * 256 + 128 + grp * 64 + 4 * hh;
#pragma unroll
            for (int nt = 0; nt < 2; ++nt)
#pragma unroll
                for (int st = 0; st < 2; ++st) Y[it] = MFMA32(ld2x8(cp + 32 * nt + 16 * st), hb[nt][st], Y[it]);
#pragma unroll
            for (int g = 0; g < 4; ++g) { const f32x4 e = *(const LAS f32x4*)(wl + 128 + 32 * it + 8 * g + 4 * hh);
                Y[it][4 * g] *= e[0]; Y[it][4 * g + 1] *= e[1]; Y[it][4 * g + 2] *= e[2]; Y[it][4 * g + 3] *= e[3]; }
        }
#pragma unroll
        for (int tl = 0; tl < 3; ++tl) {
            const int jt = tl == 0 ? 0 : (tl == 1 ? 1 : (dir == 0 ? 0 : 1)), it = tl == 0 ? 0 : (tl == 1 ? 1 : (dir == 0 ? 1 : 0));
            f32x16 s;
#pragma unroll
            for (int i = 0; i < 16; ++i) s[i] = 0.f;
            const bf16_t* bp = BCN + (size_t)(row0 + 32 * jt + r) * 256 + grp * 64 + 8 * hh;
            const bf16_t* cp = BCN + (size_t)(row0 + 32 * it + r) * 256 + 128 + grp * 64 + 8 * hh;
#pragma unroll
            for (int ks = 0; ks < 4; ++ks) s = MFMA32(*(const bf16x8*)(bp + 16 * ks), *(const bf16x8*)(cp + 16 * ks), s);
            const float ci = wl[32 * it + r];
#pragma unroll
            for (int g = 0; g < 4; ++g) { const f32x4 cj = *(const LAS f32x4*)(wl + 32 * jt + 8 * g + 4 * hh), dj = *(const LAS f32x4*)(wl + 64 + 32 * jt + 8 * g + 4 * hh);
#pragma unroll
                for (int q = 0; q < 4; ++q) { const int j = 32 * jt + 8 * g + 4 * hh + q, i = 32 * it + r; const bool ok = dir == 0 ? j <= i : j >= i;
                    s[4 * g + q] = ok ? s[4 * g + q] * __expf(ci - cj[q]) * dj[q] : 0.f; } }
#pragma unroll
            for (int st = 0; st < 2; ++st) {
                if (tl == 2) { if (dir == 0) Y[1] = MFMA32(pack8(s, 8 * st), xf[0][st], Y[1]); else Y[0] = MFMA32(pack8(s, 8 * st), xf[1][st], Y[0]); }
                else Y[tl] = MFMA32(pack8(s, 8 * st), xf[tl][st], Y[tl]);
            }
        }
#pragma unroll
        for (int it = 0; it < 2; ++it)
#pragma unroll
            for (int i = 0; i < 16; ++i) YS[(size_t)(row0 + 32 * it + crow(i, hh)) * 1024] = Y[it][i];
#pragma unroll
        for (int nt = 0; nt < 2; ++nt)
#pragma unroll
            for (int i = 0; i < 16; ++i) hT[nt][i] *= cdec;
#pragma unroll
        for (int sp = 0; sp < 4; ++sp) {
            const f32x4 w0 = *(const LAS f32x4*)(wl + 192 + 16 * sp + 4 * hh), w1 = *(const LAS f32x4*)(wl + 192 + 16 * sp + 8 + 4 * hh);
            const u32x4 xv = __builtin_bit_cast(u32x4, xf[sp >> 1][sp & 1]);
            u32x4 xw; xw.x = pk2(bflo(xv.x) * w0[0], bfhi(xv.x) * w0[1]); xw.y = pk2(bflo(xv.y) * w0[2], bfhi(xv.y) * w0[3]);
            xw.z = pk2(bflo(xv.z) * w1[0], bfhi(xv.z) * w1[1]); xw.w = pk2(bflo(xv.w) * w1[2], bfhi(xv.w) * w1[3]);
            const bf16x8 xb = __builtin_bit_cast(bf16x8, xw);
#pragma unroll
            for (int nt = 0; nt < 2; ++nt) hT[nt] = MFMA32(ld2x8(BT + (size_t)(32 * nt) * VLD + row0 + 16 * sp), xb, hT[nt]);
        }
    }
    if (!lat) { float* so = p.out + O_ST + (((((size_t)b * 4 + l) * 2 + dir) * 16 + head) * 64 + 32 * ph + r) * 64 + 4 * hh;
#pragma unroll
        for (int nt = 0; nt < 2; ++nt)
#pragma unroll
            for (int g = 0; g < 4; ++g) *(f32x4*)(so + 32 * nt + 8 * g) = (f32x4){hT[nt][4 * g], hT[nt][4 * g + 1], hT[nt][4 * g + 2], hT[nt][4 * g + 3]}; }
}
__device__ __forceinline__ void ssd_combine(const Params& p, int l, int un, int tid) {
    unsigned char* ws = p.ws;
    const bool lat = un < 128; const int b = lat ? un >> 4 : (un - 128) >> 4, head = un & 15;
    const int L = lat ? 1024 : 256, rowb = lat ? NCTX + b * 1024 : b * 256;
    const int lane = tid & 63, wave = __builtin_amdgcn_readfirstlane(tid >> 6); const float dsk = p.d_skip[l * 16 + head];
    const float* X = (const float*)(ws + WS_XACT); const float* YS = (const float*)(ws + WS_PRE);
    const bf16_t* U = (const bf16_t*)(ws + WS_U); bf16_t* YD = (bf16_t*)(ws + WS_Y) + (size_t)3 * NTOK * 1024; float* SSQ = (float*)(ws + WS_SSQ);
    for (int tk0 = wave * 4; tk0 < L; tk0 += 32) {
        float yf[4], yb[4], xv[4], zv[4];
#pragma unroll
        for (int q = 0; q < 4; ++q) { const size_t row = rowb + tk0 + q, o = row * 1024 + head * 64 + lane;
            yf[q] = YS[o]; yb[q] = YS[(size_t)NTOK * 1024 + o]; xv[q] = X[row * 1280 + head * 64 + lane]; zv[q] = bf2f(U[row * ULD + C_Z + head * 64 + lane]); }
#pragma unroll
        for (int q = 0; q < 4; ++q) { const size_t row = rowb + tk0 + q, o = row * 1024 + head * 64 + lane;
            const float y = (yf[q] + yb[q] + xv[q] * dsk) * silu_f(zv[q]);
            float s2 = y * y;
#pragma unroll
            for (int o2 = 32; o2 >= 1; o2 >>= 1) s2 += __shfl_xor(s2, o2);
            const unsigned w = pk2(y, 0.f); YD[o] = (bf16_t)(w & 0xffff);
            if (lane == 0) SSQ[row * 16 + head] = s2; }
    }
}
__device__ __forceinline__ void phase_ssd(const Params& p, int l, unsigned char* lds_g) {
    const int tid = otid(), lane = tid & 63, wave = __builtin_amdgcn_readfirstlane(tid >> 6), bid = obid();
    LAS float* wl = (LAS float*)(LAS unsigned char*)lds_g + wave * 256;
    if (bid < 128) { if (wave < 4) ssd_seq(p, l, true, bid >> 4, bid & 15, wave >> 1, wave & 1, wl, lane); }
    else if (bid < 256) {
        for (int rd = 0; rd < 2; ++rd) { const int k = wave + 8 * rd, un = (bid - 128) * 4 + (k >> 2);
            ssd_seq(p, l, false, un >> 4, un & 15, (k >> 1) & 1, k & 1, wl, lane); }
    }
    asm volatile("s_waitcnt vmcnt(0)" ::: "memory");
    __syncthreads();
    __builtin_amdgcn_fence(__ATOMIC_ACQUIRE, "agent");
    if (bid < 128) ssd_combine(p, l, bid, tid);
    else if (bid < 256) { for (int q = 0; q < 4; ++q) ssd_combine(p, l, 128 + (bid - 128) * 4 + q, tid); }
    __syncthreads();
}

#ifndef N_LAUNCH_MODE
#define N_LAUNCH_MODE 1
#endif
#ifndef DUP
#define DUP 0
#endif
#define DUPN(bit) ((DUP >> (bit)) & 1 ? 2 : 1)
#if N_LAUNCH_MODE == 1
constexpr int NPH = 2 + 9 * DEPTH;

__global__ __launch_bounds__(512, 2) void fwd(Params p_arg, int lo, int hi) {
    extern __shared__ __attribute__((aligned(16))) unsigned char lds_raw[];
    LAS unsigned char* lds = (LAS unsigned char*)lds_raw;
    const int G = gridDim.x;
    unsigned char* ws = p_arg.ws;
    volatile LAS unsigned* misc = (volatile LAS unsigned*)(lds + LDS_MISC);
    if (otid() < 4) misc[otid()] = 0u;
    __syncthreads();
    XcdBarrier bar; bar.bar = (unsigned*)(ws + WS_CTL); bar.x = 0; bar.st = misc;
    const bool multi = hi - lo > 1;
    if (multi) bar = xcd_barrier_post((unsigned*)(ws + WS_CTL), misc);
#define IN(k) (lo <= (k) && (k) < hi)
#define PP const Params p = load_params(); unsigned char* ws = p.ws; (void)ws;
#define SEAM(k) do { if (IN((k) + 1)) xcd_barrier(bar); } while (0)

    if (IN(0)) { PP for (int rep = 0; rep < DUPN(7); ++rep) phase_pro0(p, lds_raw); SEAM(0); }
    if (IN(1)) { PP phase_pro1(p); SEAM(1); }

    for (int l = 0; l < DEPTH; ++l) {
        const int pb = 2 + 9 * l;
        if (IN(pb)) { PP const float* mod = (const float*)(ws + WS_MOD); bf16_t* U = (bf16_t*)(ws + WS_U); bf16_t* H = (bf16_t*)(ws + WS_H); (void)mod; (void)U; (void)H;
            pg8::Gemm g{H, (const bf16_t*)(ws + WS_WIN) + (size_t)l * 16384 * 2048, 2048, 2048, 2048};
            pg8::PlainOrder S; S.init(NTOK, 16384, G, obid()); S.lda = 2048; S.ldb = 2048;
            pg8::EpiIn E{U, (float*)(ws + WS_DTRAW), p.out, l};
            for (int rep = 0; rep < DUPN(0); ++rep) pg8::gemm_phase(lds, g, S, E);
            SEAM(pb);
        }
        if (IN(pb + 1)) { PP const float* mod = (const float*)(ws + WS_MOD); bf16_t* U = (bf16_t*)(ws + WS_U); bf16_t* H = (bf16_t*)(ws + WS_H); (void)mod; (void)U; (void)H; phase_premix(p, l, lds_raw); if (DUPN(1) == 2) phase_premix(p, l, lds_raw, false); SEAM(pb + 1); }
        if (IN(pb + 2)) { PP const float* mod = (const float*)(ws + WS_MOD); bf16_t* U = (bf16_t*)(ws + WS_U); bf16_t* H = (bf16_t*)(ws + WS_H); (void)mod; (void)U; (void)H;
            for (int rep = 0; rep < DUPN(2); ++rep) phase_ssd(p, l, lds_raw);
            {
                LAS float* rpb = (LAS float*)lds;
                for (int i = otid(); i < 8 * 15 * 31; i += 512) rpb[i] = p.na_rpb[(size_t)l * 8 * 15 * 31 + i];
                __syncthreads();
                for (int rep = 0; rep < DUPN(3); ++rep) phase_attention(p, l, rpb);
                __syncthreads();
            }
            {
                pg8::Gemm g{(const bf16_t*)(ws + WS_POOLED), (const bf16_t*)(ws + WS_WPOOL) + (size_t)l * 4 * 256 * 256, 1024, 256, 256};
                pg8::PoolOrder S; S.init(NTOK, 1024, G, obid());
                pg8::EpiBf16<0> E{(bf16_t*)(ws + WS_Y), 1024};
                for (int rep = 0; rep < DUPN(4); ++rep) pg8::gemm_phase(lds, g, S, E);
            }
            SEAM(pb + 2);
        }
        if (IN(pb + 3)) { PP const float* mod = (const float*)(ws + WS_MOD); bf16_t* U = (bf16_t*)(ws + WS_U); bf16_t* H = (bf16_t*)(ws + WS_H); (void)mod; (void)U; (void)H;
            pg8::Gemm g{(const bf16_t*)(ws + WS_Y), (const bf16_t*)(ws + WS_WB) + (size_t)l * 4 * 2048 * 1024, 1024, 1024, 1024};
            pg8::MergeOrder S; S.init(NTOK, 2048, G, obid());
            pg8::EpiMerge E{U, (const float*)(ws + WS_SSQ), (bf16_t*)(ws + WS_MERGED)};
            for (int rep = 0; rep < DUPN(4); ++rep) pg8::gemm_phase(lds, g, S, E);
            SEAM(pb + 3);
        }
        if (IN(pb + 4)) { PP const float* mod = (const float*)(ws + WS_MOD); bf16_t* U = (bf16_t*)(ws + WS_U); bf16_t* H = (bf16_t*)(ws + WS_H); (void)mod; (void)U; (void)H;
            pg8::Gemm g{(const bf16_t*)(ws + WS_MERGED), (const bf16_t*)(ws + WS_WO) + (size_t)l * 2048 * 2048, 2048, 2048, 2048};
            pg8::PlainOrder S; S.init(NTOK, 2048, G, obid()); S.lda = 2048; S.ldb = 2048;
            pg8::EpiRes E{p.out, mod + (size_t)l * 9 * 12288, 2, (float*)(ws + WS_PRE)};
            for (int rep = 0; rep < DUPN(4); ++rep) pg8::gemm_phase(lds, g, S, E);
            SEAM(pb + 4);
        }
        if (IN(pb + 5)) { PP const float* mod = (const float*)(ws + WS_MOD); bf16_t* U = (bf16_t*)(ws + WS_U); bf16_t* H = (bf16_t*)(ws + WS_H); (void)mod; (void)U; (void)H; for (int rep = 0; rep < DUPN(5); ++rep) phase_ln(p, p.ln1_g + l * 2048, p.ln1_b + l * 2048, mod + (size_t)l * 9 * 12288, 3); SEAM(pb + 5); }
        if (IN(pb + 6)) { PP const float* mod = (const float*)(ws + WS_MOD); bf16_t* U = (bf16_t*)(ws + WS_U); bf16_t* H = (bf16_t*)(ws + WS_H); (void)mod; (void)U; (void)H;
            pg8::Gemm g{H, (const bf16_t*)(ws + WS_W1) + (size_t)l * 8192 * 2048, 2048, 2048, 2048};
            pg8::PlainOrder S; S.init(NTOK, 8192, G, obid()); S.lda = 2048; S.ldb = 2048;
            pg8::EpiBf16<1> E{U, 8192};
            for (int rep = 0; rep < DUPN(6); ++rep) pg8::gemm_phase(lds, g, S, E);
            SEAM(pb + 6);
        }
        if (IN(pb + 7)) { PP const float* mod = (const float*)(ws + WS_MOD); bf16_t* U = (bf16_t*)(ws + WS_U); bf16_t* H = (bf16_t*)(ws + WS_H); (void)mod; (void)U; (void)H;
            pg8::Gemm g{U, (const bf16_t*)(ws + WS_W2) + (size_t)l * 2048 * 8192, 8192, 8192, 8192};
            pg8::PlainOrder S; S.init(NTOK, 2048, G, obid()); S.lda = 8192; S.ldb = 8192;
            pg8::EpiRes E{p.out, mod + (size_t)l * 9 * 12288, 5, (float*)(ws + WS_PRE)};
            for (int rep = 0; rep < DUPN(6); ++rep) pg8::gemm_phase(lds, g, S, E);
            SEAM(pb + 7);
        }
        if (IN(pb + 8)) { PP const float* mod = (const float*)(ws + WS_MOD); bf16_t* U = (bf16_t*)(ws + WS_U); bf16_t* H = (bf16_t*)(ws + WS_H); (void)mod; (void)U; (void)H; for (int rep = 0; rep < DUPN(5); ++rep) phase_ln(p, p.ln2_g + l * 2048, p.ln2_b + l * 2048, l + 1 < DEPTH ? mod + (size_t)(l + 1) * 9 * 12288 : nullptr, 0); if (l + 1 < DEPTH) SEAM(pb + 8); }
    }
#undef IN
#undef SEAM
}

#else

#define LDSDECL extern __shared__ __attribute__((aligned(16))) unsigned char lds_raw[]; LAS unsigned char* lds = (LAS unsigned char*)lds_raw; unsigned char* ws = p.ws; (void)lds; (void)ws;
__global__ __launch_bounds__(512, 2) void k_pro0(Params p) { LDSDECL phase_pro0(p, lds_raw); }
__global__ __launch_bounds__(512, 2) void k_pro1(Params p) { phase_pro1(p); }
__global__ __launch_bounds__(512, 2) void k_ln(Params p, int l, int which) {
    const float* mod = (const float*)(p.ws + WS_MOD);
    if (which == 0) phase_ln(p, p.ln1_g + l * 2048, p.ln1_b + l * 2048, mod + (size_t)l * 9 * 12288, 3);
    else phase_ln(p, p.ln2_g + l * 2048, p.ln2_b + l * 2048, l + 1 < DEPTH ? mod + (size_t)(l + 1) * 9 * 12288 : nullptr, 0);
}
__global__ __launch_bounds__(512, 2) void k_premix(Params p, int l) { LDSDECL phase_premix(p, l, lds_raw); }
__global__ __launch_bounds__(512, 2) void k_ssd(Params p, int l) { LDSDECL phase_ssd(p, l, lds_raw); }
__global__ __launch_bounds__(512, 2) void k_attn(Params p, int l) { LDSDECL
    LAS float* rpb = (LAS float*)lds;
    for (int i = otid(); i < 8 * 15 * 31; i += 512) rpb[i] = p.na_rpb[(size_t)l * 8 * 15 * 31 + i];
    __syncthreads();
    phase_attention(p, l, rpb);
}
__global__ __launch_bounds__(512, 2) void k_gemm1(Params p, int l) { LDSDECL
    pg8::Gemm g{(bf16_t*)(ws + WS_H), (const bf16_t*)(ws + WS_WIN) + (size_t)l * 16384 * 2048, 2048, 2048, 2048};
    pg8::PlainOrder S; S.init(NTOK, 16384, gridDim.x, obid()); S.lda = 2048; S.ldb = 2048;
    pg8::EpiIn E{(bf16_t*)(ws + WS_U), (float*)(ws + WS_DTRAW), p.out, l};
    pg8::gemm_phase(lds, g, S, E); }
__global__ __launch_bounds__(512, 2) void k_pool(Params p, int l) { LDSDECL
    pg8::Gemm g{(const bf16_t*)(ws + WS_POOLED), (const bf16_t*)(ws + WS_WPOOL) + (size_t)l * 4 * 256 * 256, 1024, 256, 256};
    pg8::PoolOrder S; S.init(NTOK, 1024, gridDim.x, obid());
    pg8::EpiBf16<0> E{(bf16_t*)(ws + WS_Y), 1024};
    pg8::gemm_phase(lds, g, S, E); }
__global__ __launch_bounds__(512, 2) void k_merge(Params p, int l) { LDSDECL
    pg8::Gemm g{(const bf16_t*)(ws + WS_Y), (const bf16_t*)(ws + WS_WB) + (size_t)l * 4 * 2048 * 1024, 1024, 1024, 1024};
    pg8::MergeOrder S; S.init(NTOK, 2048, gridDim.x, obid());
    pg8::EpiMerge E{(bf16_t*)(ws + WS_U), (const float*)(ws + WS_SSQ), (bf16_t*)(ws + WS_MERGED)};
    pg8::gemm_phase(lds, g, S, E); }
__global__ __launch_bounds__(512, 2) void k_res(Params p, int l, int which) { LDSDECL
    const float* mod = (const float*)(ws + WS_MOD);
    if (which == 0) {
        pg8::Gemm g{(const bf16_t*)(ws + WS_MERGED), (const bf16_t*)(ws + WS_WO) + (size_t)l * 2048 * 2048, 2048, 2048, 2048};
        pg8::PlainOrder S; S.init(NTOK, 2048, gridDim.x, obid()); S.lda = 2048; S.ldb = 2048;
        pg8::EpiRes E{p.out, mod + (size_t)l * 9 * 12288, 2, (float*)(ws + WS_PRE)};
        pg8::gemm_phase(lds, g, S, E);
    } else {
        pg8::Gemm g{(bf16_t*)(ws + WS_U), (const bf16_t*)(ws + WS_W2) + (size_t)l * 2048 * 8192, 8192, 8192, 8192};
        pg8::PlainOrder S; S.init(NTOK, 2048, gridDim.x, obid()); S.lda = 8192; S.ldb = 8192;
        pg8::EpiRes E{p.out, mod + (size_t)l * 9 * 12288, 5, (float*)(ws + WS_PRE)};
        pg8::gemm_phase(lds, g, S, E);
    } }
__global__ __launch_bounds__(512, 2) void k_mlp1(Params p, int l) { LDSDECL
    pg8::Gemm g{(bf16_t*)(ws + WS_H), (const bf16_t*)(ws + WS_W1) + (size_t)l * 8192 * 2048, 2048, 2048, 2048};
    pg8::PlainOrder S; S.init(NTOK, 8192, gridDim.x, obid()); S.lda = 2048; S.ldb = 2048;
    pg8::EpiBf16<1> E{(bf16_t*)(ws + WS_U), 8192};
    pg8::gemm_phase(lds, g, S, E); }
#endif
extern "C" void kernel_launch(void* const* d_in, const int* in_sizes, int n_in, void* d_out, int out_size, void* d_ws, size_t ws_size, hipStream_t stream) {
    static int grid = 0;
    if (grid == 0) {
        if (n_in != 30 || ws_size < WS_END || (size_t)out_size != O_END) { grid = -1; return; }
        int dev = 0, cus = 0;
        if (hipGetDevice(&dev) != hipSuccess || hipDeviceGetAttribute(&cus, hipDeviceAttributeMultiprocessorCount, dev) != hipSuccess) { grid = -1; return; }
#if N_LAUNCH_MODE == 1
        if (hipFuncSetAttribute((const void*)fwd, hipFuncAttributeMaxDynamicSharedMemorySize, LDS_BYTES) != hipSuccess) { grid = -1; return; }
#else
        const void* ks[] = {(const void*)k_pro0, (const void*)k_pro1, (const void*)k_ln, (const void*)k_premix, (const void*)k_ssd, (const void*)k_attn, (const void*)k_gemm1, (const void*)k_pool,
                            (const void*)k_merge, (const void*)k_res, (const void*)k_mlp1};
        for (auto k : ks) if (hipFuncSetAttribute(k, hipFuncAttributeMaxDynamicSharedMemorySize, LDS_BYTES) != hipSuccess) { grid = -1; return; }
#endif
        grid = cus;
    }
    if (grid < 0) return;
    Params p{};
    const float** f = (const float**)&p;
    for (int i = 0; i < 30; ++i) f[i] = (const float*)d_in[i];
    p.out = (float*)d_out; p.ws = (unsigned char*)d_ws;
    (void)hipMemsetAsync((char*)d_ws + WS_CTL, 0, 65536, stream);
    const dim3 g(grid), b(512);
#if N_LAUNCH_MODE == 1
    hipLaunchKernelGGL(fwd, g, b, LDS_BYTES, stream, p, 0, NPH);
#else
    hipLaunchKernelGGL(k_pro0, g, b, LDS_BYTES, stream, p);
    hipLaunchKernelGGL(k_pro1, g, b, LDS_BYTES, stream, p);
    for (int l = 0; l < DEPTH; ++l) {
        hipLaunchKernelGGL(k_gemm1, g, b, LDS_BYTES, stream, p, l);
        hipLaunchKernelGGL(k_premix, g, b, LDS_BYTES, stream, p, l);
        hipLaunchKernelGGL(k_ssd, g, b, LDS_BYTES, stream, p, l);
        hipLaunchKernelGGL(k_attn, g, b, LDS_BYTES, stream, p, l);
        hipLaunchKernelGGL(k_pool, g, b, LDS_BYTES, stream, p, l);
        hipLaunchKernelGGL(k_merge, g, b, LDS_BYTES, stream, p, l);
        hipLaunchKernelGGL(k_res, g, b, LDS_BYTES, stream, p, l, 0);
        hipLaunchKernelGGL(k_ln, g, b, LDS_BYTES, stream, p, l, 0);
        hipLaunchKernelGGL(k_mlp1, g, b, LDS_BYTES, stream, p, l);
        hipLaunchKernelGGL(k_res, g, b, LDS_BYTES, stream, p, l, 1);
        hipLaunchKernelGGL(k_ln, g, b, LDS_BYTES, stream, p, l, 1);
    }
#endif
}
```
